# Optimizing an MI355X kernel written in HIP

```python
import jax, jax.numpy as jnp
from jax import lax
import numpy as np

D_MODEL = 1024
BATCH = 8
SEQ = 2048
DEPTH = 4
DEC_BATCH = 128
DEC_SEQ = 4
PAST_LEN = 8192
PAGE_SIZE = 128

HEAD_DIM = 64
N_Q_HEADS = 12
N_KV_HEADS = 4
GQA_GROUP = N_Q_HEADS // N_KV_HEADS
WINDOW = 128
Q_BLOCK = WINDOW
ROPE_THETA = 10000.0
CONV_CH = N_Q_HEADS * HEAD_DIM
CONV_W = 3
N_MEM = 256
N_X_HEADS = 4
X_DIM = N_X_HEADS * HEAD_DIM
D_FF = 4 * D_MODEL
N_MIXERS = 2
N_ATT_LAYERS = (DEPTH + 1) // 2
N_CONV_LAYERS = DEPTH // 2
ATT_IN = N_Q_HEADS * HEAD_DIM + 2 * N_KV_HEADS * HEAD_DIM + X_DIM
CONV_IN = 3 * CONV_CH + X_DIM
MIX_OUT = CONV_CH + X_DIM
EPS = 1e-6
NEG = -1e30

kernel_name = "hybrid_swa_sink_shortconv_memxattn_step"


def _rms_norm(x, g):
    xf = x.astype(jnp.float32)
    y = xf * lax.rsqrt(jnp.mean(xf * xf, axis=-1, keepdims=True) + EPS) * g.astype(jnp.float32)
    return y.astype(x.dtype)


def _rope(x, pos):
    half = HEAD_DIM // 2
    inv = ROPE_THETA ** (-jnp.arange(half, dtype=jnp.float32) * 2.0 / HEAD_DIM)
    ang = pos[:, None] * inv[None, :]
    cos = jnp.cos(ang)[:, None, :]
    sin = jnp.sin(ang)[:, None, :]
    xf = x.astype(jnp.float32)
    x1, x2 = xf[..., :half], xf[..., half:]
    return jnp.concatenate([x1 * cos - x2 * sin, x2 * cos + x1 * sin], axis=-1).astype(x.dtype)


def _sink_softmax(s, mask, sink):
    s = jnp.where(mask, s, NEG)
    sink = sink.astype(jnp.float32)
    m = jnp.maximum(jnp.max(s, axis=-1, keepdims=True), sink)
    p = jnp.exp(s - m)
    return p / (jnp.sum(p, axis=-1, keepdims=True) + jnp.exp(sink - m))


def _swa_prompt(q, k, v, sink):
    n, t = q.shape[0], q.shape[1]
    nb = t // Q_BLOCK
    qb = q.reshape(n, nb, Q_BLOCK, N_KV_HEADS, GQA_GROUP, HEAD_DIM)
    pad = jnp.zeros((n, Q_BLOCK, N_KV_HEADS, HEAD_DIM), k.dtype)
    kb = jnp.concatenate([pad, k], axis=1).reshape(n, nb + 1, Q_BLOCK, N_KV_HEADS, HEAD_DIM)
    vb = jnp.concatenate([pad.astype(v.dtype), v], axis=1).reshape(n, nb + 1, Q_BLOCK, N_KV_HEADS, HEAD_DIM)
    kb = jnp.concatenate([kb[:, :-1], kb[:, 1:]], axis=2)
    vb = jnp.concatenate([vb[:, :-1], vb[:, 1:]], axis=2)
    s = jnp.einsum("bnqkgd,bnskd->bnkgqs", qb, kb, preferred_element_type=jnp.float32) * (HEAD_DIM ** -0.5)
    blk = jnp.arange(nb)[:, None, None] * Q_BLOCK
    qpos = blk + jnp.arange(Q_BLOCK)[None, :, None]
    kpos = blk - Q_BLOCK + jnp.arange(2 * Q_BLOCK)[None, None, :]
    d = qpos - kpos
    mask = (d >= 0) & (d < WINDOW) & (kpos >= 0)
    mask = mask[None, :, None, None]
    pr = _sink_softmax(s, mask, sink.reshape(N_KV_HEADS, GQA_GROUP, 1, 1))
    o = jnp.einsum("bnkgqs,bnskd->bnqkgd", pr.astype(vb.dtype), vb)
    return o.reshape(n, t, N_Q_HEADS, HEAD_DIM)


def _swa_sample(q, k, v, kbuf, vbuf, sink):
    n, t = q.shape[0], q.shape[1]
    nbuf = kbuf.shape[1]
    kk = jnp.concatenate([kbuf.astype(k.dtype), k], axis=1)
    vv = jnp.concatenate([vbuf.astype(v.dtype), v], axis=1)
    qg = q.reshape(n, t, N_KV_HEADS, GQA_GROUP, HEAD_DIM)
    s = jnp.einsum("bqkgd,bskd->bkgqs", qg, kk, preferred_element_type=jnp.float32) * (HEAD_DIM ** -0.5)
    qpos = PAST_LEN + jnp.arange(t)
    kpos = PAST_LEN - nbuf + jnp.arange(nbuf + t)
    d = qpos[:, None] - kpos[None, :]
    mask = (d >= 0) & (d < WINDOW)
    pr = _sink_softmax(s, mask, sink.reshape(N_KV_HEADS, GQA_GROUP, 1, 1))
    o = jnp.einsum("bkgqs,bskd->bqkgd", pr.astype(vv.dtype), vv).reshape(n, t, N_Q_HEADS, HEAD_DIM)
    return o, kk[:, -WINDOW:], vv[:, -WINDOW:]


def _causal_conv(u, prefix, w):
    t = u.shape[1]
    full = jnp.concatenate([prefix.astype(u.dtype), u], axis=1)
    y = full[:, 0:t] * w[0]
    for j in range(1, CONV_W):
        y = y + full[:, j:j + t] * w[j]
    return y, full[:, -(CONV_W - 1):]


def _mem_kv(mem, g, w_kv, k_g):
    n = mem.shape[0]
    kv = _rms_norm(mem, g) @ w_kv
    mk = kv[..., :X_DIM].reshape(n, N_MEM, N_X_HEADS, HEAD_DIM)
    mv = kv[..., X_DIM:].reshape(n, N_MEM, N_X_HEADS, HEAD_DIM)
    return _rms_norm(mk, k_g), mv


def _cross_attend(q, mk, mv):
    s = jnp.einsum("bthd,bmhd->bhtm", q, mk.astype(q.dtype), preferred_element_type=jnp.float32) * (HEAD_DIM ** -0.5)
    p = jax.nn.softmax(s, axis=-1)
    return jnp.einsum("bhtm,bmhd->bthd", p.astype(mv.dtype), mv)


def _trunk(x, pos0, mem_k, mem_v, swa_k_in, swa_v_in, conv_in, is_prompt, p):
    n, t = x.shape[0], x.shape[1]
    pos = pos0 + jnp.arange(t, dtype=jnp.float32)
    new_k, new_v, new_conv = [], [], []
    for i in range(DEPTH):
        j = i // N_MIXERS
        h = _rms_norm(x, p["norm_mix"][i])
        if i % N_MIXERS == 0:
            z = h @ p["w_in_att"][j]
            c0 = N_Q_HEADS * HEAD_DIM
            c1 = c0 + N_KV_HEADS * HEAD_DIM
            c2 = c1 + N_KV_HEADS * HEAD_DIM
            q = z[..., :c0].reshape(n, t, N_Q_HEADS, HEAD_DIM)
            k = z[..., c0:c1].reshape(n, t, N_KV_HEADS, HEAD_DIM)
            v = z[..., c1:c2].reshape(n, t, N_KV_HEADS, HEAD_DIM)
            qx = z[..., c2:]
            q = _rope(_rms_norm(q, p["q_norm_att"][j]), pos)
            k = _rope(_rms_norm(k, p["k_norm_att"][j]), pos)
            if is_prompt:
                o_self = _swa_prompt(q, k, v, p["sinks"][j])
                kb, vb = k[:, -WINDOW:], v[:, -WINDOW:]
            else:
                o_self, kb, vb = _swa_sample(q, k, v, swa_k_in[j], swa_v_in[j], p["sinks"][j])
            new_k.append(kb)
            new_v.append(vb)
            o_self = o_self.reshape(n, t, N_Q_HEADS * HEAD_DIM)
        else:
            z = h @ p["w_in_conv"][j]
            gb = z[..., :CONV_CH]
            gc = z[..., CONV_CH:2 * CONV_CH]
            u = z[..., 2 * CONV_CH:3 * CONV_CH]
            qx = z[..., 3 * CONV_CH:]
            if is_prompt:
                prefix = jnp.zeros((n, CONV_W - 1, CONV_CH), u.dtype)
            else:
                prefix = conv_in[j]
            y, st = _causal_conv(gc * u, prefix, p["conv_w"][j])
            new_conv.append(st)
            o_self = gb * y
        qx = _rms_norm(qx.reshape(n, t, N_X_HEADS, HEAD_DIM), p["q_norm_x"][i])
        o_x = _cross_attend(qx, mem_k[i], mem_v[i]).reshape(n, t, X_DIM)
        o = jnp.concatenate([o_self, o_x.astype(o_self.dtype)], axis=-1)
        x = x + o @ p["w_out"][i]
        hm = _rms_norm(x, p["norm_mlp"][i])
        x = x + jnp.square(jax.nn.relu(hm @ p["w_up"][i])) @ p["w_down"][i]
    return x, jnp.stack(new_k), jnp.stack(new_v), jnp.stack(new_conv)


def setup_inputs(seed: int = 0) -> dict:
    key = jax.random.key(seed)
    ks = jax.random.split(key, 24)
    f32 = jnp.float32

    def nrm(k, shape, scale=1.0):
        return jax.random.normal(k, shape, f32) * scale

    def gain(k, shape):
        return 1.0 + 0.05 * jax.random.normal(k, shape, f32)

    return {
        "x_prompt": nrm(ks[0], (BATCH, SEQ, D_MODEL)),
        "x_sample": nrm(ks[1], (DEC_BATCH, DEC_SEQ, D_MODEL)),
        "mem_prompt": nrm(ks[2], (BATCH, N_MEM, D_MODEL)),
        "cache_swa_k": nrm(ks[3], (N_ATT_LAYERS, DEC_BATCH, WINDOW, N_KV_HEADS, HEAD_DIM)),
        "cache_swa_v": nrm(ks[4], (N_ATT_LAYERS, DEC_BATCH, WINDOW, N_KV_HEADS, HEAD_DIM)),
        "state_conv": nrm(ks[5], (N_CONV_LAYERS, DEC_BATCH, CONV_W - 1, CONV_CH)),
        "cache_mem_k": nrm(ks[6], (DEPTH, DEC_BATCH, N_MEM, N_X_HEADS, HEAD_DIM)),
        "cache_mem_v": nrm(ks[7], (DEPTH, DEC_BATCH, N_MEM, N_X_HEADS, HEAD_DIM)),
        "norm_mix": gain(ks[8], (DEPTH, D_MODEL)),
        "w_in_att": nrm(ks[9], (N_ATT_LAYERS, D_MODEL, ATT_IN), D_MODEL ** -0.5),
        "q_norm_att": gain(ks[10], (N_ATT_LAYERS, HEAD_DIM)),
        "k_norm_att": gain(ks[11], (N_ATT_LAYERS, HEAD_DIM)),
        "sinks": nrm(ks[12], (N_ATT_LAYERS, N_Q_HEADS), 0.5),
        "w_in_conv": nrm(ks[13], (N_CONV_LAYERS, D_MODEL, CONV_IN), D_MODEL ** -0.5),
        "conv_w": nrm(ks[14], (N_CONV_LAYERS, CONV_W, CONV_CH), CONV_W ** -0.5),
        "norm_mem": gain(ks[15], (DEPTH, D_MODEL)),
        "w_mem_kv": nrm(ks[16], (DEPTH, D_MODEL, 2 * X_DIM), D_MODEL ** -0.5),
        "q_norm_x": gain(ks[17], (DEPTH, HEAD_DIM)),
        "k_norm_x": gain(ks[18], (DEPTH, HEAD_DIM)),
        "w_out": nrm(ks[19], (DEPTH, MIX_OUT, D_MODEL), MIX_OUT ** -0.5),
        "norm_mlp": gain(ks[20], (DEPTH, D_MODEL)),
        "w_up": nrm(ks[21], (DEPTH, D_MODEL, D_FF), D_MODEL ** -0.5),
        "w_down": nrm(ks[22], (DEPTH, D_FF, D_MODEL), D_FF ** -0.5),
    }


def reference(x_prompt, x_sample, mem_prompt, cache_swa_k, cache_swa_v, state_conv, cache_mem_k, cache_mem_v,
              norm_mix, w_in_att, q_norm_att, k_norm_att, sinks, w_in_conv, conv_w, norm_mem, w_mem_kv,
              q_norm_x, k_norm_x, w_out, norm_mlp, w_up, w_down):
    p = {
        "norm_mix": norm_mix, "w_in_att": w_in_att, "q_norm_att": q_norm_att, "k_norm_att": k_norm_att,
        "sinks": sinks, "w_in_conv": w_in_conv, "conv_w": conv_w, "q_norm_x": q_norm_x,
        "w_out": w_out, "norm_mlp": norm_mlp, "w_up": w_up, "w_down": w_down,
    }
    mks, mvs = [], []
    for i in range(DEPTH):
        mk, mv = _mem_kv(mem_prompt, norm_mem[i], w_mem_kv[i], k_norm_x[i])
        mks.append(mk)
        mvs.append(mv)
    new_mem_k_prompt = jnp.stack(mks)
    new_mem_v_prompt = jnp.stack(mvs)
    y_prompt, new_swa_k_prompt, new_swa_v_prompt, new_conv_prompt = _trunk(
        x_prompt, 0.0, new_mem_k_prompt, new_mem_v_prompt, None, None, None, True, p)
    y_sample, new_swa_k_sample, new_swa_v_sample, new_conv_sample = _trunk(
        x_sample, float(PAST_LEN), cache_mem_k, cache_mem_v, cache_swa_k, cache_swa_v, state_conv, False, p)
    return (y_prompt, y_sample, new_swa_k_prompt, new_swa_v_prompt, new_conv_prompt,
            new_mem_k_prompt, new_mem_v_prompt, new_swa_k_sample, new_swa_v_sample, new_conv_sample)
```

```cpp
#include <hip/hip_runtime.h>
#include <hip/hip_cooperative_groups.h>
#include <cstdio>
#include <cstdint>
namespace cg = cooperative_groups;

namespace pg8 {
#define PG8_LAS __attribute__((address_space(3)))
typedef unsigned short bf16_t;
typedef short bf16x8 __attribute__((ext_vector_type(8)));
typedef float f32x4 __attribute__((ext_vector_type(4)));
typedef unsigned u32x4 __attribute__((ext_vector_type(4)));
constexpr int BM = 256, BK = 64, HALF = 128, HTB = HALF * BK * 2  , STAGE_BYTES = 8 * HTB, NXCD = 8, WGM = 8;

__host__ __device__ __forceinline__ int lds_byte(int r, int c) { const int st = (r >> 4) * 2 + (c >> 5), rr = r & 15, cc = c & 31, ob = rr * 64 + cc * 2; return st * 1024 + (ob ^ (((ob >> 9) & 1) << 5)); }
__host__ __device__ __forceinline__ void stage_rc(int b, int& R, int& C) { const int st = b / 1024, sb = b % 1024, swz = sb ^ (((sb >> 9) & 1) << 5); R = (st >> 1) * 16 + swz / 64; C = (st & 1) * 32 + (swz % 64) / 2; }
__host__ __device__ __forceinline__ int perm32(int rho) { const int n = rho >> 4, i = rho & 15; return 8 * (i >> 2) + 4 * n + (i & 3); }

struct Unit { int pm, pn; };
struct Gemm { const bf16_t* A; const bf16_t* Bt; int M, N, K; };

struct StaticOrder {
    int nM, nN, nwg, G, c;
    __host__ __device__ void init(int M, int N, int G_, int c_) { nM = M / BM; nN = N / BM; nwg = nM * nN; G = G_; c = c_; }
    __host__ __device__ bool next(int i, Unit& u) const {
        const long L = (long)i * G + c; if (L >= nwg) return false;
        int wgid = (int)L; { const int q = nwg / NXCD, r = nwg % NXCD, xcd = wgid % NXCD, off = wgid / NXCD; wgid = (xcd < r ? xcd * (q + 1) : r * (q + 1) + (xcd - r) * q) + off; }
        const int nig = WGM * nN, gid = wgid / nig, fm = gid * WGM, gsz = (nM - fm) < WGM ? (nM - fm) : WGM;
        u.pm = fm + ((wgid % nig) % gsz); u.pn = (wgid % nig) / gsz; return true;
    }
    __device__ __forceinline__ void a_ready(const Unit&) const {}
    __device__ __forceinline__ void done(const Unit&) const {}
};


__device__ __forceinline__ unsigned cvt_pk_bf16(float lo, float hi) { unsigned r; asm volatile("v_cvt_pk_bf16_f32 %0, %1, %2" : "=v"(r) : "v"(lo), "v"(hi)); return r; }

template <int ACT, bool RS, bool LPERM> struct EpiScale {
    static constexpr bool PERM = true, AFTER_DRAIN = false; struct Pre {}; __device__ __forceinline__ void pre(const Unit&, int, int, Pre&) const {} static constexpr int NPART = 16;
    bf16_t* O; int ldc; const float* rowss; PG8_LAS unsigned char* scr; int fast_pm;
    __device__ __forceinline__ void operator()(const f32x4 (&acc)[2][2][4][2], const Unit& u, int wr, int wc, int fr, int fq) const {
        const int row0 = u.pm * BM + wr * 64 + fr, col0 = u.pn * BM + wc * 32 + 8 * fq;
        const int lane_ = fq * 16 + fr; PG8_LAS unsigned char* ws_ = scr + (wr * 4 + wc) * 1280;
        const int woff = fr * 80 + fq * 16, roff = (lane_ >> 2) * 80 + (lane_ & 3) * 16;
        const int srow0 = u.pm * BM + wr * 64 + (lane_ >> 2), scol0 = u.pn * BM + wc * 32 + 8 * (lane_ & 3);
        float part[8];
        if (!RS) {
#pragma unroll
            for (int k = 0; k < 8; ++k) part[k] = 0.f;
        } else if (u.pm < fast_pm) {
#pragma unroll
            for (int k = 0; k < 8; ++k) part[k] = rowss[(size_t)(row0 + (k >> 2) * HALF + (k & 3) * 16) * 16 + fq];
        } else {
#pragma unroll
            for (int k = 0; k < 8; ++k) { const f32x4 a = *(const f32x4*)(rowss + (size_t)(row0 + (k >> 2) * HALF + (k & 3) * 16) * 16 + 4 * fq); part[k] = (a[0] + a[1]) + (a[2] + a[3]); }
        }
        __builtin_amdgcn_sched_barrier(0);
#pragma unroll
        for (int ai = 0; ai < 2; ++ai)
#pragma unroll
            for (int m = 0; m < 4; ++m) {
                float rs = 1.0f;
                if (RS) { float ssum = part[ai * 4 + m]; ssum += __shfl_xor(ssum, 16); ssum += __shfl_xor(ssum, 32);
                    rs = __builtin_amdgcn_rsqf(ssum * (1.0f / 1024.0f) + 1e-6f); }
#pragma unroll
                for (int bj = 0; bj < 2; ++bj) {
                    f32x4 v0 = acc[ai][bj][m][0], v1 = acc[ai][bj][m][1];
                    if (RS) { v0 = v0 * rs; v1 = v1 * rs; }
                    if (ACT == 2) {
#pragma unroll
                        for (int e = 0; e < 4; ++e) { float a = fmaxf(v0[e], 0.f), b = fmaxf(v1[e], 0.f); v0[e] = a * a; v1[e] = b * b; }
                    }
                    u32x4 w; w.x = cvt_pk_bf16(v0[0], v0[1]); w.y = cvt_pk_bf16(v0[2], v0[3]); w.z = cvt_pk_bf16(v1[0], v1[1]); w.w = cvt_pk_bf16(v1[2], v1[3]);
                    if (LPERM) { *(PG8_LAS u32x4*)(ws_ + woff) = w;
                        const u32x4 w2 = *(const PG8_LAS u32x4*)(ws_ + roff);
                        *(u32x4*)(O + (size_t)(srow0 + ai * HALF + m * 16) * ldc + scol0 + bj * HALF) = w2; }
                    else *(u32x4*)(O + (size_t)(row0 + ai * HALF + m * 16) * ldc + col0 + bj * HALF) = w;
                }
            }
    }
};
struct EpiScaleF32 {
    static constexpr bool PERM = true, AFTER_DRAIN = false; struct Pre {}; __device__ __forceinline__ void pre(const Unit&, int, int, Pre&) const {}
    float* O; int ldc; const float* rowss;
    __device__ __forceinline__ void operator()(const f32x4 (&acc)[2][2][4][2], const Unit& u, int wr, int wc, int fr, int fq) const {
        const int row0 = u.pm * BM + wr * 64 + fr, col0 = u.pn * BM + wc * 32 + 8 * fq;
#pragma unroll
        for (int ai = 0; ai < 2; ++ai)
#pragma unroll
            for (int m = 0; m < 4; ++m) {
                const int row = row0 + ai * HALF + m * 16;
                const float rs = __builtin_amdgcn_rsqf(rowss[row] * (1.0f / 1024.0f) + 1e-6f);
                float* rowp = O + (size_t)row * ldc + col0;
#pragma unroll
                for (int bj = 0; bj < 2; ++bj) {
                    *(f32x4*)(rowp + bj * HALF) = acc[ai][bj][m][0] * rs;
                    *(f32x4*)(rowp + bj * HALF + 4) = acc[ai][bj][m][1] * rs;
                }
            }
    }
};
struct EpiRes {
    static constexpr bool PERM = true, AFTER_DRAIN = false; struct Pre {}; __device__ __forceinline__ void pre(const Unit&, int, int, Pre&) const {}
    float* Y; bf16_t* XB; float* ss; const float* sc;
    __device__ __forceinline__ void operator()(const f32x4 (&acc)[2][2][4][2], const Unit& u, int wr, int wc, int fr, int fq) const {
        const int row0 = u.pm * BM + wr * 64 + fr, col0 = u.pn * BM + wc * 32 + 8 * fq;
#pragma unroll
        for (int ai = 0; ai < 2; ++ai)
#pragma unroll
            for (int m = 0; m < 4; ++m) {
                const int row = row0 + ai * HALF + m * 16;
                bf16_t* bp = XB + (size_t)row * 1024 + col0;
                float s = 0.f, rs2 = 1.0f;
                if (sc) { const f32x4 a = *(const f32x4*)(sc + (size_t)row * 16 + 4 * fq); float t = (a[0] + a[1]) + (a[2] + a[3]); t += __shfl_xor(t, 16); t += __shfl_xor(t, 32); rs2 = __builtin_amdgcn_rcpf(t * (1.0f / 1024.0f) + 1e-6f); }
#pragma unroll
                for (int bj = 0; bj < 2; ++bj) {
                    const u32x4 xw = *(const u32x4*)(bp + bj * HALF);
                    f32x4 v0 = (f32x4){__builtin_bit_cast(float, xw.x << 16), __builtin_bit_cast(float, xw.x & 0xffff0000u), __builtin_bit_cast(float, xw.y << 16), __builtin_bit_cast(float, xw.y & 0xffff0000u)} + acc[ai][bj][m][0] * rs2;
                    f32x4 v1 = (f32x4){__builtin_bit_cast(float, xw.z << 16), __builtin_bit_cast(float, xw.z & 0xffff0000u), __builtin_bit_cast(float, xw.w << 16), __builtin_bit_cast(float, xw.w & 0xffff0000u)} + acc[ai][bj][m][1] * rs2;
                    if (Y) { float* yp = Y + (size_t)row * 1024 + col0 + bj * HALF; *(f32x4*)yp = v0; *(f32x4*)(yp + 4) = v1; }
                    s += (v0[0] * v0[0] + v0[1] * v0[1]) + (v0[2] * v0[2] + v0[3] * v0[3]) + (v1[0] * v1[0] + v1[1] * v1[1]) + (v1[2] * v1[2] + v1[3] * v1[3]);
                    u32x4 w; w.x = cvt_pk_bf16(v0[0], v0[1]); w.y = cvt_pk_bf16(v0[2], v0[3]); w.z = cvt_pk_bf16(v1[0], v1[1]); w.w = cvt_pk_bf16(v1[2], v1[3]);
                    *(u32x4*)(bp + bj * HALF) = w;
                }
                s += __shfl_xor(s, 16); s += __shfl_xor(s, 32);
                if (fq == 0) ss[(size_t)row * 16 + u.pn * 4 + wc] = s;
            }
    }
};

struct EpiResT {
    static constexpr bool PERM = true, AFTER_DRAIN = true;
    typedef unsigned u32x2_p __attribute__((ext_vector_type(2)));
    struct Pre { u32x2_p xv[8]; f32x4 pv[8]; };
#define RT_ROW0(i) (u.pm * BM + 64 * ((wid * 8 + (i)) >> 5) + ((wid * 8 + (i)) & 31))
    __device__ __forceinline__ void pre(const Unit& u, int wid, int lane, Pre& P) const {
        const int col = u.pn * BM + 4 * lane;
#pragma unroll
        for (int i = 0; i < 8; ++i) { P.xv[i] = *(const u32x2_p*)(XB + (size_t)RT_ROW0(i) * 1024 + col); P.pv[i] = sc ? *(const f32x4*)(sc + (size_t)RT_ROW0(i) * 16) : (f32x4){0.f, 0.f, 0.f, 0.f}; }
    }
#undef RT_ROW0
    float* Y; bf16_t* XB; float* ss; const float* sc;
    __device__ __forceinline__ void fused(f32x4 (&acc)[2][2][4][2], const Unit& u, int wr, int wc, int fr, int fq, PG8_LAS unsigned char* lds, int wid, int lane, const Pre& P0) const {
        constexpr int LDQ = 260;
        typedef unsigned u32x2_t __attribute__((ext_vector_type(2)));
        PG8_LAS float* Q = (PG8_LAS float*)lds;
        const int col = u.pn * BM + 4 * lane;
        u32x2_t xv[8]; f32x4 pv[8];
#define RT_ROW(q, i) (u.pm * BM + 128 * ((q) >> 1) + 64 * ((wid * 8 + (i)) >> 5) + 32 * ((q) & 1) + ((wid * 8 + (i)) & 31))
#pragma unroll
        for (int i = 0; i < 8; ++i) { xv[i] = P0.xv[i]; pv[i] = P0.pv[i]; }
#pragma unroll
        for (int q = 0; q < 4; ++q) {
            const int ai = q >> 1, mh = q & 1;
#pragma unroll
            for (int mm = 0; mm < 2; ++mm)
#pragma unroll
                for (int bj = 0; bj < 2; ++bj)
#pragma unroll
                    for (int n = 0; n < 2; ++n)
                        *(PG8_LAS f32x4*)(Q + (32 * wr + 16 * mm + fr) * LDQ + 128 * bj + 32 * wc + 8 * fq + 4 * n) = acc[ai][bj][2 * mh + mm][n];
            asm volatile("s_waitcnt lgkmcnt(0)" ::: "memory"); __builtin_amdgcn_s_barrier(); asm volatile("" ::: "memory");
            f32x4 v[8];
#pragma unroll
            for (int i = 0; i < 8; ++i) v[i] = *(const PG8_LAS f32x4*)(Q + (wid * 8 + i) * LDQ + 4 * lane);
            asm volatile("s_waitcnt lgkmcnt(0)" ::: "memory"); __builtin_amdgcn_s_barrier(); asm volatile("" ::: "memory");
#pragma unroll
            for (int i = 0; i < 8; ++i) v[i] = v[i] * (sc ? __builtin_amdgcn_rcpf(((pv[i][0] + pv[i][1]) + (pv[i][2] + pv[i][3])) * (1.0f / 1024.0f) + 1e-6f) : 1.0f) + (f32x4){__builtin_bit_cast(float, xv[i].x << 16), __builtin_bit_cast(float, xv[i].x & 0xffff0000u), __builtin_bit_cast(float, xv[i].y << 16), __builtin_bit_cast(float, xv[i].y & 0xffff0000u)};
            if (q < 3) {
#pragma unroll
                for (int i = 0; i < 8; ++i) { xv[i] = *(const u32x2_t*)(XB + (size_t)RT_ROW(q + 1, i) * 1024 + col); if (sc) pv[i] = *(const f32x4*)(sc + (size_t)RT_ROW(q + 1, i) * 16); }
            }
#pragma unroll
            for (int i = 0; i < 8; ++i) {
                const int row = RT_ROW(q, i);
                if (Y) *(f32x4*)(Y + (size_t)row * 1024 + col) = v[i];
                u32x2_t w; w.x = cvt_pk_bf16(v[i][0], v[i][1]); w.y = cvt_pk_bf16(v[i][2], v[i][3]);
                *(u32x2_t*)(XB + (size_t)row * 1024 + col) = w;
                float s = (v[i][0] * v[i][0] + v[i][1] * v[i][1]) + (v[i][2] * v[i][2] + v[i][3] * v[i][3]);
#pragma unroll
                for (int o = 1; o < 64; o <<= 1) s += __shfl_xor(s, o);
                if (lane == 0) ss[(size_t)row * 16 + u.pn] = s;
            }
        }
#undef RT_ROW
    }
};


template <class Epi, class Sched, bool ALIGN_EPI = false, bool SP2 = false>
__device__ __forceinline__ void gemm_phase(PG8_LAS unsigned char* lds, const Gemm g, const Sched& S, const Epi& E) {
    int tid_l = threadIdx.x; asm volatile("" : "+v"(tid_l));
    const int tid = tid_l, wid = __builtin_amdgcn_readfirstlane(tid >> 6), lane = tid & 63, wr = wid >> 2, wc = wid & 3, fr = lane & 15, fq = lane >> 4;
    const int K = g.K, nt = K / BK;
    unsigned voffA[2], voffB[2];
#pragma unroll
    for (int i = 0; i < 2; ++i) { int R, C; stage_rc(tid * 16 + i * 8192, R, C); const int Rb = Epi::PERM ? ((R & ~31) + perm32(R & 31)) : R;
        voffA[i] = (unsigned)(R * K + C) * 2u; voffB[i] = (unsigned)(Rb * K + C) * 2u; }
    const size_t kstep = (size_t)(BK * 2);
    const size_t hstep = (size_t)HALF * K * 2;
    const size_t tstep = 2 * hstep;
    const unsigned ldsw = (unsigned)wid * 1024u;
    const int aoff = lds_byte(wr * 64 + fr, fq * 8), boff = lds_byte(wc * 32 + fr, fq * 8);
#define PG8_SA(b, h) (((b) * 2 + (h)) * HTB)
#define PG8_SB(b, h) ((4 + (b) * 2 + (h)) * HTB)
#define PG8_STAGE(bufoff, gbase, voff) do { _Pragma("unroll") for (int _i = 0; _i < 2; ++_i) \
        __builtin_amdgcn_global_load_lds((const unsigned*)((const char*)(gbase) + (voff)[_i]), (PG8_LAS unsigned*)(lds + (bufoff) + ldsw + _i * 8192), 16, 0, 0); } while (0)
#define PG8_LDA(dst, b, h) do { _Pragma("unroll") for (int m = 0; m < 4; ++m) _Pragma("unroll") for (int k = 0; k < 2; ++k) dst[m][k] = *(const PG8_LAS bf16x8*)(lds + PG8_SA(b, h) + aoff + m * 2048 + k * 1024); } while (0)
#define PG8_LDB(dst, b, h) do { _Pragma("unroll") for (int n = 0; n < 2; ++n) _Pragma("unroll") for (int k = 0; k < 2; ++k) dst[n][k] = *(const PG8_LAS bf16x8*)(lds + PG8_SB(b, h) + boff + n * 2048 + k * 1024); } while (0)
#define PG8_MMA(ai, bj, At, Bt) do { __builtin_amdgcn_s_setprio(1); _Pragma("unroll") for (int m = 0; m < 4; ++m) _Pragma("unroll") for (int n = 0; n < 2; ++n) _Pragma("unroll") for (int k = 0; k < 2; ++k) \
        acc[ai][bj][m][n] = __builtin_amdgcn_mfma_f32_16x16x32_bf16(Bt[n][k], At[m][k], acc[ai][bj][m][n], 0, 0, 0); __builtin_amdgcn_s_setprio(0); } while (0)
#define PG8_WAIT_V(n) asm volatile("s_waitcnt vmcnt(" #n ")" ::: "memory")
#define PG8_WAIT_L(n) asm volatile("s_waitcnt lgkmcnt(" #n ")" ::: "memory")
#define PG8_BAR __builtin_amdgcn_s_barrier()
#define PG8_SCHED __builtin_amdgcn_sched_barrier(0)
    Unit cur, nxt; int ui = 0;
    if (!S.next(0, cur)) return;
    f32x4 acc[2][2][4][2];
#pragma unroll
    for (int a = 0; a < 2; ++a)
#pragma unroll
        for (int b = 0; b < 2; ++b)
#pragma unroll
            for (int m = 0; m < 4; ++m)
#pragma unroll
                for (int n = 0; n < 2; ++n) acc[a][b][m][n] = (f32x4){0.f, 0.f, 0.f, 0.f};
    bf16x8 At[4][2], B0[2][2], B1[2][2];
    const char* cA = (const char*)g.A + (size_t)cur.pm * tstep; const char* cB = (const char*)g.Bt + (size_t)cur.pn * tstep;
    S.a_ready(cur);
    if constexpr (SP2) {
        PG8_STAGE(PG8_SB(0, 0), cB, voffB); PG8_STAGE(PG8_SB(0, 1), cB + hstep, voffB); PG8_STAGE(PG8_SA(0, 0), cA, voffA); PG8_STAGE(PG8_SA(0, 1), cA + hstep, voffA);
        if (wr == 1) PG8_BAR;
        PG8_WAIT_V(2); PG8_BAR;
        PG8_STAGE(PG8_SB(1, 0), cB + kstep, voffB); PG8_STAGE(PG8_SA(1, 0), cA + kstep, voffA); PG8_STAGE(PG8_SB(1, 1), cB + hstep + kstep, voffB);
        PG8_WAIT_V(6); PG8_BAR;
    } else {
        PG8_STAGE(PG8_SB(0, 0), cB, voffB); PG8_STAGE(PG8_SA(0, 0), cA, voffA); PG8_STAGE(PG8_SB(0, 1), cB + hstep, voffB); PG8_STAGE(PG8_SA(0, 1), cA + hstep, voffA);
        if (wr == 1) PG8_BAR;
        PG8_WAIT_V(4); PG8_BAR;
        PG8_STAGE(PG8_SB(1, 0), cB + kstep, voffB); PG8_STAGE(PG8_SA(1, 0), cA + kstep, voffA); PG8_STAGE(PG8_SB(1, 1), cB + hstep + kstep, voffB);
        PG8_WAIT_V(6); PG8_BAR;
    }
    for (;;) {
        const bool has_next = S.next(ui + 1, nxt);
        const char* nA = has_next ? (const char*)g.A + (size_t)nxt.pm * tstep : cA; const char* nB = has_next ? (const char*)g.Bt + (size_t)nxt.pn * tstep : cB;
        for (int t = 0; t < nt; t += 2) {
            const bool last = (t == nt - 2);
            const char* a1 = cA + (size_t)(t + 1) * kstep;
            const char* a2 = last ? nA : cA + (size_t)(t + 2) * kstep; const char* b2 = last ? nB : cB + (size_t)(t + 2) * kstep;
            const char* a3 = a2 + kstep; const char* b3 = b2 + kstep;
            if (last && has_next) S.a_ready(nxt);
            if constexpr (SP2) {
            PG8_LDB(B0, 0, 0); PG8_LDB(B1, 0, 1); PG8_SCHED; PG8_LDA(At, 0, 0); PG8_STAGE(PG8_SA(1, 1), a1 + hstep, voffA);
            PG8_WAIT_V(8); PG8_WAIT_L(0); PG8_BAR; PG8_MMA(0, 0, At, B0); PG8_MMA(0, 1, At, B1); PG8_BAR; PG8_SCHED;
            PG8_LDA(At, 0, 1); PG8_STAGE(PG8_SB(0, 0), b2, voffB); PG8_STAGE(PG8_SB(0, 1), b2 + hstep, voffB); PG8_STAGE(PG8_SA(0, 0), a2, voffA);
            PG8_WAIT_V(8); PG8_WAIT_L(0); PG8_BAR; PG8_MMA(1, 0, At, B0); PG8_MMA(1, 1, At, B1); PG8_BAR; PG8_SCHED;
            PG8_LDB(B0, 1, 0); PG8_LDB(B1, 1, 1); PG8_SCHED; PG8_LDA(At, 1, 0); PG8_STAGE(PG8_SA(0, 1), a2 + hstep, voffA);
            PG8_WAIT_V(8); PG8_WAIT_L(0); PG8_BAR; PG8_MMA(0, 0, At, B0); PG8_MMA(0, 1, At, B1); PG8_BAR; PG8_SCHED;
            PG8_LDA(At, 1, 1); PG8_STAGE(PG8_SB(1, 0), b3, voffB); PG8_STAGE(PG8_SB(1, 1), b3 + hstep, voffB); PG8_STAGE(PG8_SA(1, 0), a3, voffA);
            PG8_WAIT_V(8); PG8_WAIT_L(0); PG8_BAR; PG8_MMA(1, 0, At, B0); PG8_MMA(1, 1, At, B1); PG8_BAR; PG8_SCHED;
            } else {
            PG8_LDB(B0, 0, 0); PG8_SCHED; PG8_LDA(At, 0, 0); PG8_STAGE(PG8_SA(1, 1), a1 + hstep, voffA);
            PG8_WAIT_L(8); PG8_BAR; PG8_WAIT_L(0); PG8_MMA(0, 0, At, B0); PG8_BAR; PG8_SCHED;
            PG8_LDB(B1, 0, 1); PG8_STAGE(PG8_SB(0, 0), b2, voffB);
            PG8_BAR; PG8_WAIT_L(0); PG8_MMA(0, 1, At, B1); PG8_BAR;
            PG8_LDA(At, 0, 1); PG8_STAGE(PG8_SA(0, 0), a2, voffA);
            PG8_BAR; PG8_WAIT_L(0); PG8_MMA(1, 0, At, B0); PG8_BAR; PG8_SCHED;
            PG8_STAGE(PG8_SB(0, 1), b2 + hstep, voffB);
            PG8_WAIT_V(6); PG8_BAR; PG8_MMA(1, 1, At, B1); PG8_BAR;
            PG8_LDB(B0, 1, 0); PG8_SCHED; PG8_LDA(At, 1, 0); PG8_STAGE(PG8_SA(0, 1), a2 + hstep, voffA);
            PG8_WAIT_L(8); PG8_BAR; PG8_WAIT_L(0); PG8_MMA(0, 0, At, B0); PG8_BAR; PG8_SCHED;
            PG8_LDB(B1, 1, 1); PG8_STAGE(PG8_SB(1, 0), b3, voffB);
            PG8_BAR; PG8_WAIT_L(0); PG8_MMA(0, 1, At, B1); PG8_BAR;
            PG8_LDA(At, 1, 1); PG8_STAGE(PG8_SA(1, 0), a3, voffA);
            PG8_BAR; PG8_WAIT_L(0); PG8_MMA(1, 0, At, B0); PG8_BAR; PG8_SCHED;
            PG8_STAGE(PG8_SB(1, 1), b3 + hstep, voffB);
            PG8_WAIT_V(6); PG8_BAR; PG8_MMA(1, 1, At, B1); PG8_BAR;
            }
        }
        if constexpr (ALIGN_EPI) { if (wr == 0) PG8_BAR; }
        if constexpr (!Epi::AFTER_DRAIN) { E(acc, cur, wr, wc, fr, fq); S.done(cur); }
        if (!has_next) break;
#pragma unroll
        for (int a = 0; a < 2; ++a)
#pragma unroll
            for (int b = 0; b < 2; ++b)
#pragma unroll
                for (int m = 0; m < 4; ++m)
#pragma unroll
                    for (int n = 0; n < 2; ++n) acc[a][b][m][n] = (f32x4){0.f, 0.f, 0.f, 0.f};
        cur = nxt; cA = nA; cB = nB; ++ui;
        if constexpr (ALIGN_EPI) { if (wr == 1) PG8_BAR; }
    }
    typename Epi::Pre epre; E.pre(cur, wid, lane, epre);
    PG8_WAIT_V(0);
    if constexpr (!ALIGN_EPI) { if (wr == 0) PG8_BAR; }
    PG8_BAR;
    if constexpr (Epi::AFTER_DRAIN) { E.fused(acc, cur, wr, wc, fr, fq, lds, wid, lane, epre); S.done(cur); }
#undef PG8_SA
#undef PG8_SB
#undef PG8_STAGE
#undef PG8_LDA
#undef PG8_LDB
#undef PG8_MMA
#undef PG8_WAIT_V
#undef PG8_WAIT_L
#undef PG8_BAR
#undef PG8_SCHED
}
}

constexpr int D = 1024, NB = 8, T = 2048, MP = NB * T, NS = 128, TS = 4, MS = NS * TS, M = MP + MS;
constexpr int HD = 64, NQ = 12, NKV = 4, WIN = 128, NMEM = 256, NXH = 4, FF = 4096, DEPTH = 4;
constexpr int ATT_IN = 1536, CONV_IN = 2560, CONV_CH = 768, MEMROWS = NB * NMEM;
constexpr int NWAVES = 8, NTHR = 512;
constexpr int LDS_BYTES = 147456;
constexpr int NPH = 1 + 5 * DEPTH;
constexpr size_t MiB = 1u << 20;
constexpr size_t WS_BAR = 0;
constexpr size_t WS_MEMSS = 1 * MiB;
constexpr size_t WS_ROPE = 2 * MiB;
constexpr size_t WS_WINA = 4 * MiB;
constexpr size_t WS_WINC = 10 * MiB;
constexpr size_t WS_WMEM = 20 * MiB;
constexpr size_t WS_WOUT = 24 * MiB;
constexpr size_t WS_WUP = 32 * MiB;
constexpr size_t WS_WDN = 64 * MiB;
constexpr size_t WS_MEMB = 96 * MiB;
constexpr size_t WS_MEMRAW = 100 * MiB;
constexpr size_t WS_XB = 116 * MiB;
constexpr size_t WS_OB = 150 * MiB;
constexpr size_t WS_Z = 184 * MiB;
constexpr size_t WS_ACT = 268 * MiB;
constexpr size_t WS_ROWSS = 401 * MiB;
constexpr size_t WS_END = 411 * MiB;
static_assert(WS_XB + (size_t)M * D * 2 <= WS_OB && WS_OB + (size_t)M * D * 2 <= WS_Z && WS_Z + (size_t)M * CONV_IN * 2 <= WS_ACT && WS_ACT + (size_t)M * FF * 2 <= WS_END, "ws map");
constexpr size_t O_Y = 0;
constexpr size_t O_SWAK_P = (size_t)M * D;
constexpr size_t O_SWAV_P = O_SWAK_P + (size_t)2 * NB * WIN * NKV * HD;
constexpr size_t O_CONV_P = O_SWAV_P + (size_t)2 * NB * WIN * NKV * HD;
constexpr size_t O_MEMK_P = O_CONV_P + (size_t)2 * NB * 2 * CONV_CH;
constexpr size_t O_MEMV_P = O_MEMK_P + (size_t)DEPTH * NB * NMEM * NXH * HD;
constexpr size_t O_SWAK_S = O_MEMV_P + (size_t)DEPTH * NB * NMEM * NXH * HD;
constexpr size_t O_SWAV_S = O_SWAK_S + (size_t)2 * NS * WIN * NKV * HD;
constexpr size_t O_CONV_S = O_SWAV_S + (size_t)2 * NS * WIN * NKV * HD;
constexpr size_t O_END = O_CONV_S + (size_t)2 * NS * 2 * CONV_CH;

#define LAS __attribute__((address_space(3)))
typedef unsigned short bf16;
typedef short bf16x8 __attribute__((ext_vector_type(8)));
typedef float f32x4 __attribute__((ext_vector_type(4)));
typedef unsigned u32x4 __attribute__((ext_vector_type(4)));
typedef unsigned u32x2 __attribute__((ext_vector_type(2)));
#define LDS_WAIT() asm volatile("s_waitcnt lgkmcnt(0)" ::: "memory")

__device__ __forceinline__ unsigned f2bf(float f) { unsigned u = __builtin_bit_cast(unsigned, f); return (u + 0x7fffu + ((u >> 16) & 1u)) >> 16; }
__device__ __forceinline__ unsigned pk2(float lo, float hi) { return pg8::cvt_pk_bf16(lo, hi); }
__device__ __forceinline__ float bflo(unsigned w) { return __builtin_bit_cast(float, w << 16); }
__device__ __forceinline__ float bfhi(unsigned w) { return __builtin_bit_cast(float, w & 0xffff0000u); }
__device__ __forceinline__ float wave_sum(float v) {
#pragma unroll
    for (int o = 1; o < 64; o <<= 1) v += __shfl_xor(v, o);
    return v;
}

struct Args {
    const float* in[23]; float* out; unsigned char* ws; int ph_lo, ph_hi;
};

constexpr int SCR_WAVE_BYTES = 64 * 65 * 4;
__device__ __forceinline__ void p0_transpose_item(const float* W, int K, int N, bf16* WT, const float* gain, LAS float* scr, int item, int lane) {
    const int nblk = N / 64, kb = item / nblk, nb = item % nblk, k0 = 64 * kb, n0 = 64 * nb;
    const int kl = lane >> 4, nl = 4 * (lane & 15);
    f32x4 w[16];
#pragma unroll
    for (int i = 0; i < 16; ++i) w[i] = *(const f32x4*)(W + (size_t)(k0 + kl + 4 * i) * N + n0 + nl);
    if (gain) {
#pragma unroll
        for (int i = 0; i < 16; ++i) w[i] = w[i] * gain[k0 + kl + 4 * i];
    }
#pragma unroll
    for (int i = 0; i < 16; ++i) { LAS float* d = scr + (kl + 4 * i) * 65 + nl; d[0] = w[i].x; d[1] = w[i].y; d[2] = w[i].z; d[3] = w[i].w; }
    LDS_WAIT(); asm volatile("" ::: "memory");
    const int c = lane & 7;
#pragma unroll
    for (int j = 0; j < 8; ++j) { const int n = (lane >> 3) + 8 * j; const LAS float* s = scr + (8 * c) * 65 + n;
        u32x4 o; o.x = pk2(s[0 * 65], s[1 * 65]); o.y = pk2(s[2 * 65], s[3 * 65]); o.z = pk2(s[4 * 65], s[5 * 65]); o.w = pk2(s[6 * 65], s[7 * 65]);
        *(u32x4*)(WT + (size_t)(n0 + n) * K + k0 + 8 * c) = o; }
    LDS_WAIT(); asm volatile("" ::: "memory");
}
__device__ __forceinline__ float row_to_bf16(const float* xrow, bf16* orow, float* crow, int lane) {
    const f32x4* xr = (const f32x4*)xrow + lane; float s = 0.f;
    f32x4 v[4];
#pragma unroll
    for (int j = 0; j < 4; ++j) { v[j] = xr[64 * j]; s += (v[j].x * v[j].x + v[j].y * v[j].y) + (v[j].z * v[j].z + v[j].w * v[j].w); }
    u32x2* o8 = (u32x2*)orow + lane;
#pragma unroll
    for (int j = 0; j < 4; ++j) { u32x2 w; w.x = pk2(v[j].x, v[j].y); w.y = pk2(v[j].z, v[j].w); o8[64 * j] = w; }
    if (crow) { f32x4* c = (f32x4*)crow + lane;
#pragma unroll
        for (int j = 0; j < 4; ++j) c[64 * j] = v[j]; }
    return wave_sum(s);
}
__device__ const double INV_FREQ[32] = {1.0, 0.7498942093324558, 0.5623413251903491, 0.4216965034285822, 0.3162277660168379, 0.23713737056616546, 0.17782794100389226, 0.1333521432163324,
    0.09999999999999998, 0.07498942093324555, 0.056234132519034884, 0.04216965034285822, 0.031622776601683784, 0.02371373705661654, 0.017782794100389226, 0.01333521432163323,
    0.009999999999999995, 0.007498942093324557, 0.005623413251903487, 0.004216965034285821, 0.0031622776601683764, 0.0023713737056616536, 0.001778279410038922, 0.0013335214321633228,
    0.0009999999999999994, 0.0007498942093324555, 0.0005623413251903486, 0.00042169650342858197, 0.00031622776601683783, 0.00023713737056616532, 0.00017782794100389203, 0.00013335214321633237};
__device__ __forceinline__ void sincos_d(double ang, float& c, float& s) {
    const double TWO_PI = 6.283185307179586476925286766559;
    const double k = __builtin_rint(ang * (1.0 / TWO_PI));
    const double r = ang - k * TWO_PI, r2 = r * r;
    double sn = 1.0, cs = 1.0;
#pragma unroll
    for (int n = 14; n >= 1; --n) { sn = 1.0 - sn * r2 * (1.0 / (double)((2 * n) * (2 * n + 1))); cs = 1.0 - cs * r2 * (1.0 / (double)((2 * n - 1) * (2 * n))); }
    s = (float)(sn * r); c = (float)cs;
}

constexpr int KS_STRIDE = 144, VT_STRIDE = 528, KS_OFF = 0, VT_OFF = 256 * KS_STRIDE;
template <bool F32> __device__ __forceinline__ void ld8(const void* p, float (&v)[8]) {
    if (F32) { const f32x4 a = ((const f32x4*)p)[0], b = ((const f32x4*)p)[1]; v[0] = a.x; v[1] = a.y; v[2] = a.z; v[3] = a.w; v[4] = b.x; v[5] = b.y; v[6] = b.z; v[7] = b.w; }
    else { const u32x4 w = *(const u32x4*)p; v[0] = bflo(w.x); v[1] = bfhi(w.x); v[2] = bflo(w.y); v[3] = bfhi(w.y); v[4] = bflo(w.z); v[5] = bfhi(w.z); v[6] = bflo(w.w); v[7] = bfhi(w.w); }
}
__device__ __forceinline__ void ld8f_nt(const float* p, float (&v)[8]) { const f32x4 a = __builtin_nontemporal_load((const f32x4*)p), b = __builtin_nontemporal_load((const f32x4*)p + 1);
    v[0] = a.x; v[1] = a.y; v[2] = a.z; v[3] = a.w; v[4] = b.x; v[5] = b.y; v[6] = b.z; v[7] = b.w; }
__device__ __forceinline__ void st8f_nt(float* p, const float (&v)[8]) { __builtin_nontemporal_store((f32x4){v[0], v[1], v[2], v[3]}, (f32x4*)p); __builtin_nontemporal_store((f32x4){v[4], v[5], v[6], v[7]}, (f32x4*)p + 1); }
__device__ __forceinline__ void st8f(float* p, const float (&v)[8]) { ((f32x4*)p)[0] = (f32x4){v[0], v[1], v[2], v[3]}; ((f32x4*)p)[1] = (f32x4){v[4], v[5], v[6], v[7]}; }
__device__ __forceinline__ u32x4 pk8(const float (&v)[8]) { u32x4 w; w.x = pk2(v[0], v[1]); w.y = pk2(v[2], v[3]); w.z = pk2(v[4], v[5]); w.w = pk2(v[6], v[7]); return w; }
template <int X1, int X2, bool NORM, bool ROPE>
__device__ __forceinline__ void norm_rope16(float (&a)[8], float (&b)[8], int jq, const float* gain, const float* cs) {
    if (NORM) {
        float s = 0.f;
#pragma unroll
        for (int i = 0; i < 8; ++i) s += a[i] * a[i] + b[i] * b[i];
        s += __shfl_xor(s, X1); s += __shfl_xor(s, X2);
        const float r = __builtin_amdgcn_rsqf(s * (1.0f / 64.0f) + 1e-6f);
        float ga[8], gb[8]; ld8<true>(gain + 8 * jq, ga); ld8<true>(gain + 32 + 8 * jq, gb);
#pragma unroll
        for (int i = 0; i < 8; ++i) { a[i] = a[i] * r * ga[i]; b[i] = b[i] * r * gb[i]; }
    }
    if (ROPE) {
        float c[8], sn[8]; ld8<true>(cs + 8 * jq, c); ld8<true>(cs + 32 + 8 * jq, sn);
#pragma unroll
        for (int i = 0; i < 8; ++i) { const float x1 = a[i], x2 = b[i]; a[i] = x1 * c[i] - x2 * sn[i]; b[i] = x2 * c[i] + x1 * sn[i]; }
    }
}
template <bool F32, bool NORM, bool ROPE, bool NT = false>
__device__ __forceinline__ void stage_k(LAS unsigned char* Ks, int slot, int jq, const void* src, const float* gain, const float* cs, float* outf) {
    float a[8], b[8]; constexpr int ES = F32 ? 4 : 2;
    if (NT) { ld8f_nt((const float*)src + 8 * jq, a); ld8f_nt((const float*)src + 32 + 8 * jq, b); }
    else { ld8<F32>((const char*)src + 8 * jq * ES, a); ld8<F32>((const char*)src + (32 + 8 * jq) * ES, b); }
    norm_rope16<1, 2, NORM, ROPE>(a, b, jq, gain, cs);
    if (outf) { if (NT) { st8f_nt(outf + 8 * jq, a); st8f_nt(outf + 32 + 8 * jq, b); } else { st8f(outf + 8 * jq, a); st8f(outf + 32 + 8 * jq, b); } }
    *(LAS u32x4*)(Ks + slot * KS_STRIDE + 16 * jq) = pk8(a); *(LAS u32x4*)(Ks + slot * KS_STRIDE + 64 + 16 * jq) = pk8(b);
}
template <bool F32, bool NT = false>
__device__ __forceinline__ void stage_v(LAS unsigned char* Vt, int slot, int jq, const void* src, float* outf) {
    float a[8], b[8]; constexpr int ES = F32 ? 4 : 2;
    if (NT) { ld8f_nt((const float*)src + 16 * jq, a); ld8f_nt((const float*)src + 16 * jq + 8, b); }
    else { ld8<F32>((const char*)src + 16 * jq * ES, a); ld8<F32>((const char*)src + (16 * jq + 8) * ES, b); }
    if (outf) { if (NT) { st8f_nt(outf + 16 * jq, a); st8f_nt(outf + 16 * jq + 8, b); } else { st8f(outf + 16 * jq, a); st8f(outf + 16 * jq + 8, b); } }
#pragma unroll
    for (int i = 0; i < 8; ++i) { *(LAS bf16*)(Vt + (16 * jq + i) * VT_STRIDE + slot * 2) = (bf16)f2bf(a[i]); *(LAS bf16*)(Vt + (16 * jq + 8 + i) * VT_STRIDE + slot * 2) = (bf16)f2bf(b[i]); }
}
__device__ __forceinline__ void stage_zero(LAS unsigned char* Ks, LAS unsigned char* Vt, int slot, int jq) {
    *(LAS u32x4*)(Ks + slot * KS_STRIDE + 16 * jq) = (u32x4){0u, 0u, 0u, 0u}; *(LAS u32x4*)(Ks + slot * KS_STRIDE + 64 + 16 * jq) = (u32x4){0u, 0u, 0u, 0u};
#pragma unroll
    for (int i = 0; i < 16; ++i) *(LAS bf16*)(Vt + (16 * jq + i) * VT_STRIDE + slot * 2) = (bf16)0;
}
template <bool ROPE>
__device__ __forceinline__ void load_q(const bf16* src, int q4, const float* gain, const float* cs, bf16x8& f0, bf16x8& f1) {
    float a[8], b[8];
    ld8<false>(src + 8 * q4, a); ld8<false>(src + 32 + 8 * q4, b);
    norm_rope16<16, 32, true, ROPE>(a, b, q4, gain, cs);
#pragma unroll
    for (int i = 0; i < 8; ++i) { a[i] *= 0.18033688011112042f; b[i] *= 0.18033688011112042f; }
    f0 = __builtin_bit_cast(bf16x8, pk8(a)); f1 = __builtin_bit_cast(bf16x8, pk8(b));
}
template <int NT>
__device__ __forceinline__ void attn_rows16(const LAS unsigned char* Ks, const LAS unsigned char* Vt, int t0, bf16x8 q0, bf16x8 q1, int lo, int hi, float sink, bf16* outp, bool valid, int lane) {
    const int r16 = lane & 15, q4 = lane >> 4;
    f32x4 s[NT];
#pragma unroll
    for (int kt = 0; kt < NT; ++kt) {
        const LAS unsigned char* kp = Ks + (16 * (t0 + kt) + r16) * KS_STRIDE + 16 * q4;
        const bf16x8 k0 = *(const LAS bf16x8*)kp, k1 = *(const LAS bf16x8*)(kp + 64);
        f32x4 c = {0.f, 0.f, 0.f, 0.f};
        c = __builtin_amdgcn_mfma_f32_16x16x32_bf16(k0, q0, c, 0, 0, 0);
        c = __builtin_amdgcn_mfma_f32_16x16x32_bf16(k1, q1, c, 0, 0, 0);
        s[kt] = c;
    }
    sink *= 1.4426950408889634f;
    float m = sink;
#pragma unroll
    for (int kt = 0; kt < NT; ++kt)
#pragma unroll
        for (int i = 0; i < 4; ++i) { const int j = 16 * (t0 + kt) + 4 * q4 + i; const float v = (j >= lo && j <= hi) ? s[kt][i] : -1e30f; s[kt][i] = v; m = fmaxf(m, v); }
    m = fmaxf(m, __shfl_xor(m, 16)); m = fmaxf(m, __shfl_xor(m, 32));
    float sum = 0.f;
#pragma unroll
    for (int kt = 0; kt < NT; ++kt)
#pragma unroll
        for (int i = 0; i < 4; ++i) { const float p = __builtin_amdgcn_exp2f(s[kt][i] - m); s[kt][i] = p; sum += p; }
    sum += __shfl_xor(sum, 16); sum += __shfl_xor(sum, 32);
    sum += __builtin_amdgcn_exp2f(sink - m);
    const float inv = 1.0f / sum;
    f32x4 o[4];
#pragma unroll
    for (int dt = 0; dt < 4; ++dt) o[dt] = (f32x4){0.f, 0.f, 0.f, 0.f};
#pragma unroll
    for (int kb = 0; kb < NT / 2; ++kb) {
        u32x4 pw; pw.x = pk2(s[2 * kb][0], s[2 * kb][1]); pw.y = pk2(s[2 * kb][2], s[2 * kb][3]);
        pw.z = pk2(s[2 * kb + 1][0], s[2 * kb + 1][1]); pw.w = pk2(s[2 * kb + 1][2], s[2 * kb + 1][3]);
        const bf16x8 pf = __builtin_bit_cast(bf16x8, pw);
#pragma unroll
        for (int dt = 0; dt < 4; ++dt) {
            const LAS unsigned char* vp = Vt + (16 * dt + r16) * VT_STRIDE + (16 * (t0 + 2 * kb) + 4 * q4) * 2;
            const u32x2 v0 = *(const LAS u32x2*)vp, v1 = *(const LAS u32x2*)(vp + 32);
            const bf16x8 vf = __builtin_bit_cast(bf16x8, (u32x4){v0.x, v0.y, v1.x, v1.y});
            o[dt] = __builtin_amdgcn_mfma_f32_16x16x32_bf16(vf, pf, o[dt], 0, 0, 0);
        }
    }
    if (valid) {
#pragma unroll
        for (int dt = 0; dt < 4; ++dt) { u32x2 w; w.x = pk2(o[dt][0] * inv, o[dt][1] * inv); w.y = pk2(o[dt][2] * inv, o[dt][3] * inv); *(u32x2*)(outp + 16 * dt) = w; }
    }
}
#define XB_TMO      128
#define XB_XCNT(j)  (256  + 64 * (j))
#define XB_XSUB(j)  (1280 + 64 * (j))
#define XB_XGEN(j)  (2304 + 64 * (j))
#define XB_TOP      3328
#define XB_TOPGEN   3392
#define XCD_BAR_WORDS 3456
#define XB_SPIN_CAP (1u << 18)

__device__ __forceinline__ unsigned xb_ld(unsigned* p)              { return __hip_atomic_load(p, __ATOMIC_RELAXED, __HIP_MEMORY_SCOPE_AGENT); }
__device__ __forceinline__ unsigned xb_add(unsigned* p, unsigned v) { return __hip_atomic_fetch_add(p, v, __ATOMIC_RELAXED, __HIP_MEMORY_SCOPE_AGENT); }
__device__ __forceinline__ unsigned xb_xcc_id() { return (unsigned)__builtin_amdgcn_s_getreg((3 << 11) | 20) & 0xFu; }
#define XB_SPIN(cond, bar) do { unsigned _sp = 0; while (cond) { __builtin_amdgcn_s_sleep(1); \
    if ((++_sp & 255u) == 0u) { if (xb_ld(&(bar)[XB_TMO])) break; if (_sp > XB_SPIN_CAP) { atomicAdd(&(bar)[XB_TMO], 1u); break; } } } } while (0)

struct XcdBarrier {
    unsigned* bar; unsigned x;
    volatile LAS unsigned* st;
};

__device__ __forceinline__ XcdBarrier xcd_barrier_post(unsigned* bar, volatile LAS unsigned* st) {
    XcdBarrier b; b.bar = bar; b.x = xb_xcc_id(); b.st = st;
    if (threadIdx.x == 0) (void)xb_add(&bar[XB_XCNT(b.x)], 1u);
    return b;
}
__device__ __forceinline__ void xcd_barrier_complete(unsigned* bar, unsigned x, unsigned& nloc, unsigned& nx) {
    const unsigned G = gridDim.x * gridDim.y * gridDim.z;
    unsigned sum, cnt, mine, sp = 0u;
    for (;;) {
        sum = 0u; cnt = 0u; mine = 0u;
#pragma unroll
        for (unsigned j = 0; j < 16; ++j) { const unsigned c = xb_ld(&bar[XB_XCNT(j)]); sum += c; cnt += (c > 0u) ? 1u : 0u; mine = (j == x) ? c : mine; }
        if (sum == G) break;
        __builtin_amdgcn_s_sleep(1);
        if ((++sp & 255u) == 0u) { if (xb_ld(&bar[XB_TMO])) break; if (sp > XB_SPIN_CAP) { atomicAdd(&bar[XB_TMO], 1u); break; } }
    }
    nloc = mine > 0u ? mine : 1u; nx = cnt > 0u ? cnt : 1u;
}

__device__ __forceinline__ void xcd_barrier(const XcdBarrier& b) {
    asm volatile("s_waitcnt vmcnt(0)" ::: "memory");
    __syncthreads();
    if (threadIdx.x == 0) {
        unsigned* bar = b.bar;
        __builtin_amdgcn_s_waitcnt(0);
        unsigned nloc = b.st[0], nx = b.st[1];
        if (nloc == 0u) { xcd_barrier_complete(bar, b.x, nloc, nx); b.st[0] = nloc; b.st[1] = nx; }
        const unsigned old = xb_add(&bar[XB_XSUB(b.x)], 1u);
        const unsigned gen = old / nloc;
        if (old + 1u == (gen + 1u) * nloc) {
            __builtin_amdgcn_fence(__ATOMIC_RELEASE, "agent");
            asm volatile("s_waitcnt vmcnt(0)" ::: "memory");
            const unsigned og = xb_add(&bar[XB_TOP], 1u);
            const unsigned tg = og / nx;
            if (og + 1u == (tg + 1u) * nx) xb_add(&bar[XB_TOPGEN], 1u);
            else XB_SPIN(xb_ld(&bar[XB_TOPGEN]) == tg, bar);
            __builtin_amdgcn_fence(__ATOMIC_ACQUIRE, "agent");
            xb_add(&bar[XB_XGEN(b.x)], 1u);
            asm volatile("s_waitcnt vmcnt(0)" ::: "memory");
        } else {
            XB_SPIN(xb_ld(&bar[XB_XGEN(b.x)]) == gen, bar);
            __builtin_amdgcn_fence(__ATOMIC_ACQUIRE, "agent");
            asm volatile("s_waitcnt vmcnt(0)" ::: "memory");
        }
    }
    __syncthreads();
}


template <int ACT, bool RS> struct SkScale {
    bf16* O; int ldc; const float* rowss;
    __device__ __forceinline__ void apply(int row, int col, float (&v)[8], int tid) const {
        float rs = 1.0f;
        if (RS) { const f32x4* sp = (const f32x4*)(rowss + (size_t)row * 16); const f32x4 a = sp[0], b = sp[1], c = sp[2], d = sp[3];
            const float ssum = (((a[0] + a[1]) + (a[2] + a[3])) + ((b[0] + b[1]) + (b[2] + b[3]))) + (((c[0] + c[1]) + (c[2] + c[3])) + ((d[0] + d[1]) + (d[2] + d[3])));
            rs = __builtin_amdgcn_rsqf(ssum * (1.0f / 1024.0f) + 1e-6f); }
#pragma unroll
        for (int i = 0; i < 8; ++i) { float x = v[i] * rs; if (ACT == 2) { x = fmaxf(x, 0.f); x = x * x; } v[i] = x; }
        *(u32x4*)(O + (size_t)row * ldc + col) = pk8(v);
    }
};
struct SkRes {
    float* Y; bf16* XB; float* ss; const float* sc;
    __device__ __forceinline__ void apply(int row, int col, float (&v)[8], int tid) const {
        if (sc) { const f32x4* sp = (const f32x4*)(sc + (size_t)row * 16); const f32x4 a = sp[0], b = sp[1], c = sp[2], d = sp[3];
            const float ssum = (((a[0] + a[1]) + (a[2] + a[3])) + ((b[0] + b[1]) + (b[2] + b[3]))) + (((c[0] + c[1]) + (c[2] + c[3])) + ((d[0] + d[1]) + (d[2] + d[3])));
            const float rs2 = __builtin_amdgcn_rcpf(ssum * (1.0f / 1024.0f) + 1e-6f);
#pragma unroll
            for (int i = 0; i < 8; ++i) v[i] *= rs2; }
        bf16* bp = XB + (size_t)row * D + col; float x[8]; ld8<false>(bp, x); float s = 0.f;
#pragma unroll
        for (int i = 0; i < 8; ++i) { x[i] += v[i]; s += x[i] * x[i]; }
        if (Y) st8f(Y + (size_t)row * D + col, x);
        *(u32x4*)bp = pk8(x);
        s += __shfl_xor(s, 1); s += __shfl_xor(s, 2); s += __shfl_xor(s, 4);
        if ((tid & 7) == 0) ss[(size_t)row * 16 + (col >> 6)] = s;
    }
};
template <int NTW, int WN, int WK, class Epi>
__device__ __forceinline__ void skinny_unit(LAS unsigned char* lds, const bf16* A, const bf16* Bt, int K, int r0, int n0, const Epi& E, int tid) {
    constexpr int NC = 16 * NTW * WN, LDP = NC + 4;
    static_assert(WN * WK == NWAVES && WK * 32 * LDP * 4 <= 131072, "skinny layout");
    const int lane = tid & 63, wave = __builtin_amdgcn_readfirstlane(tid >> 6), wn = wave % WN, wk = wave / WN;
    const int r16 = lane & 15, q4 = lane >> 4;
    const int KW = K / WK;
    const bf16* ap = A + (size_t)(r0 + (lane >> 2)) * K + wk * KW + 8 * (lane & 3);
    const bf16* bp = Bt + (size_t)(n0 + wn * 16 * NTW + (lane >> 2)) * K + wk * KW + 8 * (lane & 3);
    constexpr int SLOT = 16 * 80, NSLOT = 2 * (2 + NTW);
    static_assert(NWAVES * NSLOT * SLOT <= 131072, "skinny permute scratch");
    LAS unsigned char* wsc = lds + wave * (NSLOT * SLOT);
    const int woff = (lane >> 2) * 80 + (lane & 3) * 16, roff = r16 * 80 + q4 * 16;
    f32x4 acc[2][NTW];
#pragma unroll
    for (int nt = 0; nt < NTW; ++nt) { acc[0][nt] = (f32x4){0.f, 0.f, 0.f, 0.f}; acc[1][nt] = (f32x4){0.f, 0.f, 0.f, 0.f}; }
    bf16x8 sa0[2][2], sb0[2][NTW], sa1[2][2], sb1[2][NTW];
#define SK_LOAD(sa, sb, kk) do { _Pragma("unroll") for (int u_ = 0; u_ < 2; ++u_) { sa[u_][0] = *(const bf16x8*)(ap + (kk) + 32 * u_); sa[u_][1] = *(const bf16x8*)(ap + (size_t)16 * K + (kk) + 32 * u_); \
        _Pragma("unroll") for (int nt = 0; nt < NTW; ++nt) sb[u_][nt] = *(const bf16x8*)(bp + (size_t)nt * 16 * K + (kk) + 32 * u_); } } while (0)
#define SK_PERM(sa, sb) do { _Pragma("unroll") for (int u_ = 0; u_ < 2; ++u_) { *(LAS bf16x8*)(wsc + (u_ * (2 + NTW) + 0) * SLOT + woff) = sa[u_][0]; *(LAS bf16x8*)(wsc + (u_ * (2 + NTW) + 1) * SLOT + woff) = sa[u_][1]; \
        _Pragma("unroll") for (int nt = 0; nt < NTW; ++nt) *(LAS bf16x8*)(wsc + (u_ * (2 + NTW) + 2 + nt) * SLOT + woff) = sb[u_][nt]; } \
        _Pragma("unroll") for (int u_ = 0; u_ < 2; ++u_) { sa[u_][0] = *(const LAS bf16x8*)(wsc + (u_ * (2 + NTW) + 0) * SLOT + roff); sa[u_][1] = *(const LAS bf16x8*)(wsc + (u_ * (2 + NTW) + 1) * SLOT + roff); \
        _Pragma("unroll") for (int nt = 0; nt < NTW; ++nt) sb[u_][nt] = *(const LAS bf16x8*)(wsc + (u_ * (2 + NTW) + 2 + nt) * SLOT + roff); } } while (0)
#define SK_MMA(sa, sb) do { _Pragma("unroll") for (int u_ = 0; u_ < 2; ++u_) _Pragma("unroll") for (int nt = 0; nt < NTW; ++nt) { \
        acc[0][nt] = __builtin_amdgcn_mfma_f32_16x16x32_bf16(sb[u_][nt], sa[u_][0], acc[0][nt], 0, 0, 0); acc[1][nt] = __builtin_amdgcn_mfma_f32_16x16x32_bf16(sb[u_][nt], sa[u_][1], acc[1][nt], 0, 0, 0); } } while (0)
    SK_LOAD(sa0, sb0, 0);
#pragma unroll 1
    for (int k = 0; k < KW; k += 128) {
        SK_LOAD(sa1, sb1, k + 64);
        __builtin_amdgcn_sched_barrier(0);
        SK_PERM(sa0, sb0); SK_MMA(sa0, sb0);
        __builtin_amdgcn_sched_barrier(0);
        if (k + 128 < KW) SK_LOAD(sa0, sb0, k + 128);
        __builtin_amdgcn_sched_barrier(0);
        SK_PERM(sa1, sb1); SK_MMA(sa1, sb1);
        __builtin_amdgcn_sched_barrier(0);
    }
#undef SK_LOAD
#undef SK_PERM
#undef SK_MMA
    __syncthreads();
    LAS float* P = (LAS float*)lds;
#pragma unroll
    for (int mt = 0; mt < 2; ++mt)
#pragma unroll
        for (int nt = 0; nt < NTW; ++nt) *(LAS f32x4*)(P + (wk * 32 + mt * 16 + r16) * LDP + wn * 16 * NTW + nt * 16 + 4 * q4) = acc[mt][nt];
    __syncthreads();
#pragma unroll 1
    for (int it = tid; it < 32 * (NC / 8); it += NTHR) {
        const int row = it / (NC / 8), c8 = (it % (NC / 8)) * 8;
        float v[8];
#pragma unroll
        for (int i = 0; i < 8; ++i) v[i] = 0.f;
#pragma unroll
        for (int w = 0; w < WK; ++w) { const LAS f32x4* pp = (const LAS f32x4*)(P + (w * 32 + row) * LDP + c8); const f32x4 x = pp[0], y = pp[1];
            v[0] += x[0]; v[1] += x[1]; v[2] += x[2]; v[3] += x[3]; v[4] += y[0]; v[5] += y[1]; v[6] += y[2]; v[7] += y[3]; }
        E.apply(r0 + row, n0 + c8, v, tid);
    }
    __syncthreads();
}
template <int NTW, int WN, int WK, class Epi>
__device__ __forceinline__ void skinny_gemm(LAS unsigned char* lds, const bf16* A, const bf16* Bt, int K, const Epi& E, int u0, int nu, int tid) {
    constexpr int NC = 16 * NTW * WN;
#pragma unroll 1
    for (int u = u0; u < u0 + nu; ++u) skinny_unit<NTW, WN, WK, Epi>(lds, A, Bt, K, MP + 32 * (u >> 4), NC * (u & 15), E, tid);
}

template <int PART>
__device__ __forceinline__ void item_swa_prompt(const Args& A, LAS unsigned char* lds, int it, int j, int tid, int wave, int lane) {
    const int qb = it & 15, g = (it >> 4) & 3, b = it >> 6;
    const bf16* Z = (const bf16*)(A.ws + WS_Z); bf16* OB = (bf16*)(A.ws + WS_OB); const float* rope = (const float*)(A.ws + WS_ROPE);
    LAS unsigned char* Ks = lds + KS_OFF; LAS unsigned char* Vt = lds + VT_OFF;
    const float* kg = A.in[11] + j * HD; const float* qg = A.in[10] + j * HD;
    const int jq = tid & 3;
    if (PART != 2) {
#pragma unroll 1
    for (int pass = 0; pass < 2; ++pass) {
        const int slot = pass * 128 + (tid >> 2), pos = (qb - 1) * 128 + slot;
        if (pos < 0) stage_zero(Ks, Vt, slot, jq);
        else {
            const size_t row = (size_t)b * T + pos; const bool last = (qb == 15) && (pass == 1);
            const size_t oo = ((((size_t)j * NB + b) * WIN + (slot - 128)) * NKV + g) * HD;
            stage_k<false, true, true>(Ks, slot, jq, Z + row * ATT_IN + 768 + g * HD, kg, rope + (size_t)pos * 64, last ? A.out + O_SWAK_P + oo : nullptr);
            stage_v<false>(Vt, slot, jq, Z + row * ATT_IN + 1024 + g * HD, last ? A.out + O_SWAV_P + oo : nullptr);
        }
    }
    }
    if (PART == 0) __syncthreads();
    const int r16 = lane & 15, q4 = lane >> 4;
    if (PART != 1 && (PART == 0 || wave >= 1)) {
    const int g0 = (PART == 0) ? wave : wave - 1, gs = (PART == 0) ? NWAVES : NWAVES - 1;
#pragma unroll 1
    for (int gk = 0; gk < 4; ++gk) { const int gi = g0 + gk * gs; if (gi >= 24) break;
        const int hh = gi >> 3, qg16 = gi & 7, i = 16 * qg16 + r16, hq = g * 3 + hh, pos = qb * 128 + i;
        const size_t row = (size_t)b * T + pos;
        bf16x8 q0, q1; load_q<true>(Z + row * ATT_IN + hq * HD, q4, qg, rope + (size_t)pos * 64, q0, q1);
        int lo = i + 1; if (qb == 0 && lo < 128) lo = 128;
        attn_rows16<10>(Ks, Vt, 2 * (qg16 >> 1), q0, q1, lo, i + 128, A.in[12][j * NQ + hq], OB + row * D + hq * HD + 4 * q4, true, lane);
    }
    }
    if (PART == 0) __syncthreads();
}
template <int PART>
__device__ __forceinline__ void item_cross_prompt(const Args& A, LAS unsigned char* lds, int it, int li, int ldz, int xcol, int tid, int wave, int lane) {
    const int qp = it & 7, h = (it >> 3) & 3, b = it >> 5;
    const bf16* Z = (const bf16*)(A.ws + WS_Z); bf16* OB = (bf16*)(A.ws + WS_OB); const float* MR = (const float*)(A.ws + WS_MEMRAW);
    LAS unsigned char* Ks = lds + KS_OFF; LAS unsigned char* Vt = lds + VT_OFF;
    const float* kg = A.in[18] + li * HD; const float* qg = A.in[17] + li * HD;
    const int jq = tid & 3;
    if (PART != 2) {
#pragma unroll 1
    for (int pass = 0; pass < 2; ++pass) {
        const int slot = pass * 128 + (tid >> 2);
        const float* src = MR + (size_t)(b * NMEM + slot) * 2048 + li * 512 + h * HD;
        const size_t oo = ((((size_t)li * NB + b) * NMEM + slot) * NXH + h) * HD;
        stage_k<true, true, false>(Ks, slot, jq, src, kg, nullptr, qp == 0 ? A.out + O_MEMK_P + oo : nullptr);
        stage_v<true>(Vt, slot, jq, src + 256, qp == 0 ? A.out + O_MEMV_P + oo : nullptr);
    }
    }
    if (PART == 0) __syncthreads();
    const int r16 = lane & 15, q4 = lane >> 4;
    if (PART != 1 && (PART == 0 || wave >= 1)) {
    const int g0 = (PART == 0) ? wave : wave - 1, gs = (PART == 0) ? NWAVES : NWAVES - 1;
#pragma unroll 1
    for (int gk = 0; gk < 3; ++gk) { const int gi = g0 + gk * gs; if (gi >= 16) break;
        const size_t row = (size_t)b * T + qp * 256 + 16 * gi + r16;
        bf16x8 q0, q1; load_q<false>(Z + row * ldz + xcol + h * HD, q4, qg, nullptr, q0, q1);
        attn_rows16<16>(Ks, Vt, 0, q0, q1, 0, 255, -1e30f, OB + row * D + CONV_CH + h * HD + 4 * q4, true, lane);
    }
    }
    if (PART == 0) __syncthreads();
}
template <int PART>
__device__ __forceinline__ void item_swa_sample(const Args& A, LAS unsigned char* lds, int it, int j, int tid, int wave, int lane) {
    const int g = it & 3, b = it >> 2;
    const bf16* Z = (const bf16*)(A.ws + WS_Z); bf16* OB = (bf16*)(A.ws + WS_OB); const float* rope = (const float*)(A.ws + WS_ROPE);
    LAS unsigned char* Ks = lds + KS_OFF; LAS unsigned char* Vt = lds + VT_OFF;
    const float* kg = A.in[11] + j * HD; const float* qg = A.in[10] + j * HD;
    const int jq = tid & 3;
    if (PART != 2) {
    {
        const int slot = tid >> 2;
        const size_t so = ((((size_t)j * NS + b) * WIN + slot) * NKV + g) * HD, oo = ((((size_t)j * NS + b) * WIN + (slot - 4)) * NKV + g) * HD;
        stage_k<true, false, false>(Ks, slot, jq, A.in[3] + so, nullptr, nullptr, slot >= 4 ? A.out + O_SWAK_S + oo : nullptr);
        stage_v<true>(Vt, slot, jq, A.in[4] + so, slot >= 4 ? A.out + O_SWAV_S + oo : nullptr);
    }
    if (tid < 128) {
        const int slot = 128 + (tid >> 2), t = slot - 128;
        if (t < TS) {
            const size_t row = (size_t)MP + b * TS + t, oo = ((((size_t)j * NS + b) * WIN + (slot - 4)) * NKV + g) * HD;
            stage_k<false, true, true>(Ks, slot, jq, Z + row * ATT_IN + 768 + g * HD, kg, rope + (size_t)(T + t) * 64, A.out + O_SWAK_S + oo);
            stage_v<false>(Vt, slot, jq, Z + row * ATT_IN + 1024 + g * HD, A.out + O_SWAV_S + oo);
        } else stage_zero(Ks, Vt, slot, jq);
    }
    }
    if (PART == 0) __syncthreads();
    if (PART != 1 && wave == 0) {
        const int r16 = lane & 15, q4 = lane >> 4;
        const bool valid = r16 < 12; const int hh = valid ? (r16 >> 2) : 2, t = r16 & 3, hq = g * 3 + hh;
        const size_t row = (size_t)MP + b * TS + t;
        bf16x8 q0, q1; load_q<true>(Z + row * ATT_IN + hq * HD, q4, qg, rope + (size_t)(T + t) * 64, q0, q1);
        attn_rows16<10>(Ks, Vt, 0, q0, q1, t + 1, 128 + t, A.in[12][j * NQ + hq], OB + row * D + hq * HD + 4 * q4, valid, lane);
    }
    if (PART == 0) __syncthreads();
}
template <int PART>
__device__ __forceinline__ void item_cross_sample(const Args& A, LAS unsigned char* lds, int it, int li, int ldz, int xcol, int tid, int wave, int lane) {
    const int h = it & 3, b = it >> 2;
    const bf16* Z = (const bf16*)(A.ws + WS_Z); bf16* OB = (bf16*)(A.ws + WS_OB);
    LAS unsigned char* Ks = lds + KS_OFF; LAS unsigned char* Vt = lds + VT_OFF;
    const float* qg = A.in[17] + li * HD;
    const int jq = tid & 3;
    if (PART != 2) {
#pragma unroll
    for (int pass = 0; pass < 2; ++pass) {
        const int slot = pass * 128 + (tid >> 2);
        const size_t so = ((((size_t)li * NS + b) * NMEM + slot) * NXH + h) * HD;
        stage_k<true, false, false>(Ks, slot, jq, A.in[6] + so, nullptr, nullptr, nullptr);
        stage_v<true>(Vt, slot, jq, A.in[7] + so, nullptr);
    }
    }
    if (PART == 0) __syncthreads();
    if (PART != 1 && wave == 0) {
        const int r16 = lane & 15, q4 = lane >> 4;
        const bool valid = r16 < 4; const int t = r16 & 3;
        const size_t row = (size_t)MP + b * TS + t;
        bf16x8 q0, q1; load_q<false>(Z + row * ldz + xcol + h * HD, q4, qg, nullptr, q0, q1);
        attn_rows16<16>(Ks, Vt, 0, q0, q1, 0, 255, -1e30f, OB + row * D + CONV_CH + h * HD + 4 * q4, valid, lane);
    }
    if (PART == 0) __syncthreads();
}
struct SReg { unsigned w[32]; };
__device__ __forceinline__ void cross_sample_load(const Args& A, int it, int li, int tid, SReg& R) {
    const int h = it & 3, b = it >> 2, jq = tid & 3;
#pragma unroll
    for (int pass = 0; pass < 2; ++pass) {
        const int slot = pass * 128 + (tid >> 2);
        const size_t so = ((((size_t)li * NS + b) * NMEM + slot) * NXH + h) * HD;
        float a[8], c[8];
        ld8<true>(A.in[6] + so + 8 * jq, a); ld8<true>(A.in[6] + so + 32 + 8 * jq, c);
        const u32x4 ka = pk8(a), kc = pk8(c);
        ld8<true>(A.in[7] + so + 16 * jq, a); ld8<true>(A.in[7] + so + 16 * jq + 8, c);
        const u32x4 va = pk8(a), vc = pk8(c);
        R.w[pass * 16 + 0] = ka.x; R.w[pass * 16 + 1] = ka.y; R.w[pass * 16 + 2] = ka.z; R.w[pass * 16 + 3] = ka.w;
        R.w[pass * 16 + 4] = kc.x; R.w[pass * 16 + 5] = kc.y; R.w[pass * 16 + 6] = kc.z; R.w[pass * 16 + 7] = kc.w;
        R.w[pass * 16 + 8] = va.x; R.w[pass * 16 + 9] = va.y; R.w[pass * 16 + 10] = va.z; R.w[pass * 16 + 11] = va.w;
        R.w[pass * 16 + 12] = vc.x; R.w[pass * 16 + 13] = vc.y; R.w[pass * 16 + 14] = vc.z; R.w[pass * 16 + 15] = vc.w;
    }
}
__device__ __forceinline__ void cross_sample_finish(LAS unsigned char* lds, int tid, const SReg& R) {
    LAS unsigned char* Ks = lds + KS_OFF; LAS unsigned char* Vt = lds + VT_OFF; const int jq = tid & 3;
#pragma unroll
    for (int pass = 0; pass < 2; ++pass) {
        const int slot = pass * 128 + (tid >> 2);
        *(LAS u32x4*)(Ks + slot * KS_STRIDE + 16 * jq) = (u32x4){R.w[pass * 16 + 0], R.w[pass * 16 + 1], R.w[pass * 16 + 2], R.w[pass * 16 + 3]};
        *(LAS u32x4*)(Ks + slot * KS_STRIDE + 64 + 16 * jq) = (u32x4){R.w[pass * 16 + 4], R.w[pass * 16 + 5], R.w[pass * 16 + 6], R.w[pass * 16 + 7]};
#pragma unroll
        for (int i = 0; i < 8; ++i) { const unsigned v = R.w[pass * 16 + 8 + i];
            *(LAS bf16*)(Vt + (16 * jq + 2 * i) * VT_STRIDE + slot * 2) = (bf16)(v & 0xffffu); *(LAS bf16*)(Vt + (16 * jq + 2 * i + 1) * VT_STRIDE + slot * 2) = (bf16)(v >> 16); }
    }
}
__device__ __forceinline__ void swa_sample_load(const Args& A, int it, int j, int tid, SReg& R) {
    const int g = it & 3, b = it >> 2, jq = tid & 3, slot = tid >> 2;
    const size_t so = ((((size_t)j * NS + b) * WIN + slot) * NKV + g) * HD;
    float a[8], c[8];
    ld8<true>(A.in[3] + so + 8 * jq, a); ld8<true>(A.in[3] + so + 32 + 8 * jq, c);
#pragma unroll
    for (int i = 0; i < 8; ++i) { R.w[i] = __builtin_bit_cast(unsigned, a[i]); R.w[8 + i] = __builtin_bit_cast(unsigned, c[i]); }
    ld8<true>(A.in[4] + so + 16 * jq, a); ld8<true>(A.in[4] + so + 16 * jq + 8, c);
#pragma unroll
    for (int i = 0; i < 8; ++i) { R.w[16 + i] = __builtin_bit_cast(unsigned, a[i]); R.w[24 + i] = __builtin_bit_cast(unsigned, c[i]); }
}
__device__ __forceinline__ void swa_sample_finish(const Args& A, LAS unsigned char* lds, int it, int j, int tid, const SReg& R) {
    const int g = it & 3, b = it >> 2, jq = tid & 3;
    const bf16* Z = (const bf16*)(A.ws + WS_Z); const float* rope = (const float*)(A.ws + WS_ROPE);
    LAS unsigned char* Ks = lds + KS_OFF; LAS unsigned char* Vt = lds + VT_OFF;
    {
        const int slot = tid >> 2;
        float ka[8], kc[8], va[8], vc[8];
#pragma unroll
        for (int i = 0; i < 8; ++i) { ka[i] = __builtin_bit_cast(float, R.w[i]); kc[i] = __builtin_bit_cast(float, R.w[8 + i]); va[i] = __builtin_bit_cast(float, R.w[16 + i]); vc[i] = __builtin_bit_cast(float, R.w[24 + i]); }
        if (slot >= 4) { const size_t oo = ((((size_t)j * NS + b) * WIN + (slot - 4)) * NKV + g) * HD;
            st8f(A.out + O_SWAK_S + oo + 8 * jq, ka); st8f(A.out + O_SWAK_S + oo + 32 + 8 * jq, kc);
            st8f(A.out + O_SWAV_S + oo + 16 * jq, va); st8f(A.out + O_SWAV_S + oo + 16 * jq + 8, vc); }
        *(LAS u32x4*)(Ks + slot * KS_STRIDE + 16 * jq) = pk8(ka); *(LAS u32x4*)(Ks + slot * KS_STRIDE + 64 + 16 * jq) = pk8(kc);
#pragma unroll
        for (int i = 0; i < 8; ++i) { *(LAS bf16*)(Vt + (16 * jq + i) * VT_STRIDE + slot * 2) = (bf16)f2bf(va[i]); *(LAS bf16*)(Vt + (16 * jq + 8 + i) * VT_STRIDE + slot * 2) = (bf16)f2bf(vc[i]); }
    }
    if (tid < 128) {
        const int slot = 128 + (tid >> 2), t = slot - 128;
        if (t < TS) {
            const size_t row = (size_t)MP + b * TS + t, oo = ((((size_t)j * NS + b) * WIN + (slot - 4)) * NKV + g) * HD;
            stage_k<false, true, true>(Ks, slot, jq, Z + row * ATT_IN + 768 + g * HD, A.in[11] + j * HD, rope + (size_t)(T + t) * 64, A.out + O_SWAK_S + oo);
            stage_v<false>(Vt, slot, jq, Z + row * ATT_IN + 1024 + g * HD, A.out + O_SWAV_S + oo);
        } else stage_zero(Ks, Vt, slot, jq);
    }
}
__device__ __forceinline__ void conv_items(const Args& A, int j, int gtid, int gthreads) {
    const bf16* Z = (const bf16*)(A.ws + WS_Z); bf16* OB = (bf16*)(A.ws + WS_OB);
    const float* cw = A.in[14] + (size_t)j * 3 * CONV_CH;
#pragma unroll 1
    for (int it = gtid; it < M * 96; it += gthreads) {
        const int row = it / 96, c0 = (it % 96) * 8;
        int t, b; const bool prompt = row < MP;
        if (prompt) { b = row / T; t = row % T; } else { b = (row - MP) / TS; t = (row - MP) % TS; }
        const bf16* zr = Z + (size_t)row * CONV_IN + c0;
        float gb[8], gc[8], u[8], cu0[8], cu1[8], cu2[8], w0[8], w1[8], w2[8];
        ld8<false>(zr, gb); ld8<false>(zr + CONV_CH, gc); ld8<false>(zr + 2 * CONV_CH, u);
#pragma unroll
        for (int i = 0; i < 8; ++i) cu2[i] = gc[i] * u[i];
        if (t >= 1) { ld8<false>(zr - CONV_IN + CONV_CH, gc); ld8<false>(zr - CONV_IN + 2 * CONV_CH, u);
#pragma unroll
            for (int i = 0; i < 8; ++i) cu1[i] = gc[i] * u[i]; }
        else if (prompt) {
#pragma unroll
            for (int i = 0; i < 8; ++i) cu1[i] = 0.f; }
        else ld8<true>(A.in[5] + (((size_t)j * NS + b) * 2 + 1) * CONV_CH + c0, cu1);
        if (t >= 2) { ld8<false>(zr - 2 * CONV_IN + CONV_CH, gc); ld8<false>(zr - 2 * CONV_IN + 2 * CONV_CH, u);
#pragma unroll
            for (int i = 0; i < 8; ++i) cu0[i] = gc[i] * u[i]; }
        else if (prompt) {
#pragma unroll
            for (int i = 0; i < 8; ++i) cu0[i] = 0.f; }
        else ld8<true>(A.in[5] + (((size_t)j * NS + b) * 2 + t) * CONV_CH + c0, cu0);
        ld8<true>(cw + c0, w0); ld8<true>(cw + CONV_CH + c0, w1); ld8<true>(cw + 2 * CONV_CH + c0, w2);
        float o[8];
#pragma unroll
        for (int i = 0; i < 8; ++i) o[i] = gb[i] * (w0[i] * cu0[i] + w1[i] * cu1[i] + w2[i] * cu2[i]);
        *(u32x4*)(OB + (size_t)row * D + c0) = pk8(o);
        if (prompt) { if (t >= T - 2) st8f(A.out + O_CONV_P + (((size_t)j * NB + b) * 2 + (t - (T - 2))) * CONV_CH + c0, cu2); }
        else { if (t >= TS - 2) st8f(A.out + O_CONV_S + (((size_t)j * NS + b) * 2 + (t - (TS - 2))) * CONV_CH + c0, cu2); }
    }
}

#ifndef TEST_MASK
#define TEST_MASK 63
#endif
constexpr int PHMASK = TEST_MASK;
#ifndef MIX_REP
#define MIX_REP 1
#endif
#ifndef P0_REP
#define P0_REP 1
#endif
__global__ void __launch_bounds__(NTHR, 2) trunk_fwd(Args A) {
    extern __shared__ __attribute__((aligned(16))) unsigned char lds_raw[];
    LAS unsigned char* lds = (LAS unsigned char*)lds_raw;
    cg::grid_group grid = cg::this_grid();
    if (threadIdx.x < 4) ((volatile LAS unsigned*)(lds + 147440))[threadIdx.x] = 0u;
    __syncthreads();
    const XcdBarrier xbar = xcd_barrier_post((unsigned*)(A.ws + WS_BAR), (volatile LAS unsigned*)(lds + 147440));
    if (A.ph_lo > A.ph_hi) grid.sync();
    const int tid0 = threadIdx.x;
#define LAUNDER_TID() int tid = tid0; asm volatile("" : "+v"(tid)); const int lane = tid & 63, wave = __builtin_amdgcn_readfirstlane(tid >> 6); (void)lane; (void)wave
    const int G = gridDim.x, bx = blockIdx.x;
    const int lo = A.ph_lo, hi = A.ph_hi;
    unsigned char* ws = A.ws;
    float* rowss = (float*)(ws + WS_ROWSS); float* memss = (float*)(ws + WS_MEMSS);
    bf16* XB = (bf16*)(ws + WS_XB); bf16* OB = (bf16*)(ws + WS_OB); bf16* Z = (bf16*)(ws + WS_Z); bf16* ACT = (bf16*)(ws + WS_ACT);
    float* X = A.out + O_Y;
#define IN(k) (lo <= (k) && (k) < hi)
#define SEAM(k) do { if (IN(k) && IN((k) + 1)) { asm volatile("s_waitcnt vmcnt(0) lgkmcnt(0)" ::: "memory"); xcd_barrier(xbar); } } while (0)

    if (IN(0) && (PHMASK & 1)) {
      for (int rep = 0; rep < P0_REP; ++rep) {
        LAUNDER_TID();
        LAS float* scr = (LAS float*)(lds + wave * SCR_WAVE_BYTES);
        const int gw = bx * NWAVES + wave, NGW = G * NWAVES, gtid = bx * NTHR + tid, gthreads = G * NTHR;
        for (int i = gtid; i < (T + TS) * 32; i += gthreads) { const int p = i >> 5, f = i & 31; const double pos = (p < T) ? (double)p : (double)(8192 + p - T);
            float c, s; sincos_d(pos * INV_FREQ[f], c, s); float* rt = (float*)(ws + WS_ROPE) + (size_t)p * 64; rt[f] = c; rt[32 + f] = s; }
        for (int m = gw; m < M + MEMROWS; m += NGW) {
            if (m < M) { const float* src = (m < MP) ? A.in[0] + (size_t)m * D : A.in[1] + (size_t)(m - MP) * D;
                const float s = row_to_bf16(src, XB + (size_t)m * D, nullptr, lane); if (lane < 16) rowss[(size_t)m * 16 + lane] = (lane == 0) ? s : 0.f; }
            else { const int r = m - M; const float s = row_to_bf16(A.in[2] + (size_t)r * D, (bf16*)(ws + WS_MEMB) + (size_t)r * D, nullptr, lane); if (lane == 0) memss[r] = s; }
        }
        constexpr int I_INA = 16 * 24, I_INC = 16 * 40, I_MEM = 16 * 8, I_OUT = 16 * 16, I_UP = 16 * 64, I_DN = 64 * 16;
        constexpr int NITEMS = 2 * I_INA + 2 * I_INC + 4 * I_MEM + 4 * I_OUT + 4 * I_UP + 4 * I_DN;
#pragma unroll 1
        for (int it = gw; it < NITEMS; it += NGW) {
            int r = it;
            if (r < 2 * I_INA) { const int l = r / I_INA; p0_transpose_item(A.in[9] + (size_t)l * D * ATT_IN, D, ATT_IN, (bf16*)(ws + WS_WINA) + (size_t)l * ATT_IN * D, A.in[8] + (2 * l) * D, scr, r % I_INA, lane); continue; } r -= 2 * I_INA;
            if (r < 2 * I_INC) { const int l = r / I_INC; p0_transpose_item(A.in[13] + (size_t)l * D * CONV_IN, D, CONV_IN, (bf16*)(ws + WS_WINC) + (size_t)l * CONV_IN * D, A.in[8] + (2 * l + 1) * D, scr, r % I_INC, lane); continue; } r -= 2 * I_INC;
            if (r < 4 * I_MEM) { const int l = r / I_MEM; p0_transpose_item(A.in[16] + (size_t)l * D * 512, D, 512, (bf16*)(ws + WS_WMEM) + (size_t)l * 512 * D, A.in[15] + l * D, scr, r % I_MEM, lane); continue; } r -= 4 * I_MEM;
            if (r < 4 * I_OUT) { const int l = r / I_OUT; p0_transpose_item(A.in[19] + (size_t)l * D * D, D, D, (bf16*)(ws + WS_WOUT) + (size_t)l * D * D, nullptr, scr, r % I_OUT, lane); continue; } r -= 4 * I_OUT;
            if (r < 4 * I_UP) { const int l = r / I_UP; p0_transpose_item(A.in[21] + (size_t)l * D * FF, D, FF, (bf16*)(ws + WS_WUP) + (size_t)l * FF * D, A.in[20] + l * D, scr, r % I_UP, lane); continue; } r -= 4 * I_UP;
            { const int l = r / I_DN; p0_transpose_item(A.in[22] + (size_t)l * FF * D, FF, D, (bf16*)(ws + WS_WDN) + (size_t)l * D * FF, nullptr, scr, r % I_DN, lane); }
        }
        __syncthreads();
      }
    }
    SEAM(0);

#pragma unroll 1
    for (int li = 0; li < DEPTH; ++li) {
        const int p0 = 1 + 5 * li, j = li >> 1; const bool att = (li & 1) == 0;
        const int nin = att ? ATT_IN : CONV_IN, xcol = att ? 1280 : 2304;
        if (IN(p0) && (PHMASK & 2)) {
            const bf16* W = att ? (const bf16*)(ws + WS_WINA) + (size_t)j * ATT_IN * D : (const bf16*)(ws + WS_WINC) + (size_t)j * CONV_IN * D;
            pg8::Gemm g{XB, W, M, nin, D}; pg8::StaticOrder S; S.init(M, nin, G, bx);
            pg8::EpiScale<0, true, true> E{Z, nin, rowss + (size_t)(2 * li) * M * 16, lds + 131072, (G == 256) ? MP / 256 : 0};
            pg8::gemm_phase<pg8::EpiScale<0, true, true>, pg8::StaticOrder, true, true>(lds, g, S, E);
            if (li == 0) {
                pg8::Gemm g2{(const bf16*)(ws + WS_MEMB), (const bf16*)(ws + WS_WMEM), MEMROWS, 2048, D}; pg8::StaticOrder S2; S2.init(MEMROWS, 2048, G, G - 1 - bx);
                pg8::EpiScaleF32 E2{(float*)(ws + WS_MEMRAW), 2048, memss};
                pg8::gemm_phase<pg8::EpiScaleF32, pg8::StaticOrder, true, true>(lds, g2, S2, E2);
            }
        }
        SEAM(p0);
        if (IN(p0 + 1) && (PHMASK & 4)) {
          for (int rep = 0; rep < MIX_REP; ++rep) {
            LAUNDER_TID();
            if (G == 256) {
                constexpr int REG1 = 70656;
                const int nP = att ? 3 : 1, nS = att ? 4 : 2;
                SReg R;
                if (att) swa_sample_load(A, bx, j, tid, R); else cross_sample_load(A, bx, li, tid, R);
#pragma unroll 1
                for (int k = 0; k < nS; ++k) {
                    const bool hp = k < nP, swp = att && k < 2, sws = att && k < 2;
                    const int its = bx + ((att ? (k & 1) : k) << 8);
                    if (hp) { if (swp) item_swa_prompt<1>(A, lds, bx + (k << 8), j, tid, wave, lane); else item_cross_prompt<1>(A, lds, bx, li, nin, xcol, tid, wave, lane); }
                    if (sws) swa_sample_finish(A, lds + REG1, its, j, tid, R); else cross_sample_finish(lds + REG1, tid, R);
                    __syncthreads();
                    if (k + 1 < nS) {
                        const int k1 = k + 1, its1 = bx + ((att ? (k1 & 1) : k1) << 8);
                        if (att && k1 < 2) swa_sample_load(A, its1, j, tid, R); else cross_sample_load(A, its1, li, tid, R);
                    }
                    if (hp) { if (swp) item_swa_prompt<2>(A, lds, bx + (k << 8), j, tid, wave, lane); else item_cross_prompt<2>(A, lds, bx, li, nin, xcol, tid, wave, lane); }
                    if (sws) item_swa_sample<2>(A, lds + REG1, its, j, tid, wave, lane); else item_cross_sample<2>(A, lds + REG1, its, li, nin, xcol, tid, wave, lane);
                    __syncthreads();
                }
            } else {
            if (att) {
#pragma unroll 1
                for (int it = bx; it < 512; it += G) item_swa_prompt<0>(A, lds, it, j, tid, wave, lane);
            }
#pragma unroll 1
            for (int it = bx; it < 256; it += G) item_cross_prompt<0>(A, lds, it, li, nin, xcol, tid, wave, lane);
            if (att) {
#pragma unroll 1
                for (int it = bx; it < 512; it += G) item_swa_sample<0>(A, lds, it, j, tid, wave, lane);
            }
#pragma unroll 1
            for (int it = bx; it < 512; it += G) item_cross_sample<0>(A, lds, it, li, nin, xcol, tid, wave, lane);
            }
            if (!att) conv_items(A, j, bx * NTHR + tid, G * NTHR);
          }
        }
        SEAM(p0 + 1);
        if (IN(p0 + 2) && (PHMASK & 8)) {
            const bf16* W = (const bf16*)(ws + WS_WOUT) + (size_t)li * D * D;
            pg8::Gemm g{OB, W, MP, D, D}; pg8::StaticOrder S; S.init(MP, D, G, bx);
            pg8::EpiRes E{nullptr, XB, rowss + (size_t)(2 * li + 1) * M * 16, nullptr};
            if (G == 256) { pg8::EpiResT ET{nullptr, XB, rowss + (size_t)(2 * li + 1) * M * 16, nullptr}; pg8::gemm_phase<pg8::EpiResT, pg8::StaticOrder, true, true>(lds, g, S, ET); }
            else pg8::gemm_phase<pg8::EpiRes, pg8::StaticOrder, true, true>(lds, g, S, E);
            { LAUNDER_TID(); SkRes SE{nullptr, XB, rowss + (size_t)(2 * li + 1) * M * 16, nullptr}; skinny_gemm<4, 1, 8, SkRes>(lds, OB, W, D, SE, bx, 1, tid); }
        }
        SEAM(p0 + 2);
        if (IN(p0 + 3) && (PHMASK & 16)) {
            const bf16* W = (const bf16*)(ws + WS_WUP) + (size_t)li * FF * D;
            pg8::Gemm g{XB, W, MP, FF, D}; pg8::StaticOrder S; S.init(MP, FF, G, bx);
            pg8::EpiScale<2, false, true> E{ACT, FF, nullptr, lds + 131072, 0};
            pg8::gemm_phase<pg8::EpiScale<2, false, true>, pg8::StaticOrder, true, true>(lds, g, S, E);
            { LAUNDER_TID(); SkScale<2, false> SE{ACT, FF, nullptr}; skinny_gemm<4, 4, 2, SkScale<2, false>>(lds, XB, W, D, SE, bx, 1, tid); }
        }
        SEAM(p0 + 3);
        if (IN(p0 + 4) && (PHMASK & 32)) {
            const bf16* W = (const bf16*)(ws + WS_WDN) + (size_t)li * D * FF;
            pg8::Gemm g{ACT, W, MP, D, FF}; pg8::StaticOrder S; S.init(MP, D, G, bx);
            pg8::EpiRes E{(li == DEPTH - 1) ? X : nullptr, XB, rowss + (size_t)(2 * li + 2) * M * 16, rowss + (size_t)(2 * li + 1) * M * 16};
            if (G == 256) { pg8::EpiResT ET{(li == DEPTH - 1) ? X : nullptr, XB, rowss + (size_t)(2 * li + 2) * M * 16, rowss + (size_t)(2 * li + 1) * M * 16}; pg8::gemm_phase<pg8::EpiResT, pg8::StaticOrder, true, true>(lds, g, S, ET); }
            else pg8::gemm_phase<pg8::EpiRes, pg8::StaticOrder, true, true>(lds, g, S, E);
            { LAUNDER_TID(); SkRes SE{(li == DEPTH - 1) ? X : nullptr, XB, rowss + (size_t)(2 * li + 2) * M * 16, rowss + (size_t)(2 * li + 1) * M * 16}; skinny_gemm<4, 1, 8, SkRes>(lds, ACT, W, FF, SE, bx, 1, tid); }
        }
        SEAM(p0 + 4);
    }
#undef IN
#undef SEAM
}

#ifndef N_LAUNCHES
#define N_LAUNCHES 1
#endif
extern "C" void kernel_launch(void* const* d_in, const int* in_sizes, int n_in, void* d_out, int out_size, void* d_ws, size_t ws_size, hipStream_t stream) {
    static int grid = 0;
    if (grid == 0) {
        if (n_in != 23 || (size_t)out_size != O_END || ws_size < WS_END) { fprintf(stderr, "kernel_launch: unexpected shapes: n_in %d out %d ws %zu\n", n_in, out_size, ws_size); grid = -1; return; }
        int dev = 0, cus = 0, per_cu = 0;
        if (hipGetDevice(&dev) != hipSuccess || hipDeviceGetAttribute(&cus, hipDeviceAttributeMultiprocessorCount, dev) != hipSuccess) { grid = -1; return; }
        if (hipFuncSetAttribute((const void*)trunk_fwd, hipFuncAttributeMaxDynamicSharedMemorySize, LDS_BYTES) != hipSuccess) { fprintf(stderr, "kernel_launch: hipFuncSetAttribute failed\n"); grid = -1; return; }
        if (hipOccupancyMaxActiveBlocksPerMultiprocessor(&per_cu, (const void*)trunk_fwd, NTHR, LDS_BYTES) != hipSuccess || per_cu < 1) { fprintf(stderr, "kernel_launch: occupancy query failed (%d)\n", per_cu); (void)hipGetLastError(); grid = -1; return; }
        grid = cus * per_cu;
        fprintf(stderr, "kernel_launch: grid %d (cus %d x %d)\n", grid, cus, per_cu);
    }
    if (grid < 0) return;
    if (hipMemsetAsync((char*)d_ws + WS_BAR, 0, XCD_BAR_WORDS * 4, stream) != hipSuccess) { fprintf(stderr, "kernel_launch: memset failed\n"); return; }
    Args a{};
    for (int i = 0; i < 23; ++i) a.in[i] = (const float*)d_in[i];
    a.out = (float*)d_out; a.ws = (unsigned char*)d_ws;
#if N_LAUNCHES == 1
    a.ph_lo = 0; a.ph_hi = NPH;
    void* args[] = {&a};
    hipError_t e = hipLaunchCooperativeKernel((const void*)trunk_fwd, dim3(grid), dim3(NTHR), args, LDS_BYTES, stream);
    if (e != hipSuccess) fprintf(stderr, "kernel_launch: cooperative launch failed: %s (grid %d)\n", hipGetErrorString(e), grid);
#else
    for (int p = 0; p < NPH; ++p) { a.ph_lo = p; a.ph_hi = p + 1; hipLaunchKernelGGL(trunk_fwd, dim3(grid), dim3(NTHR), LDS_BYTES, stream, a); }
#endif
}
```

```cpp
#include <hip/hip_runtime.h>
#include <hip/hip_cooperative_groups.h>
#include <cstdio>
#include <cstdint>
namespace cg = cooperative_groups;

namespace pg8 {
#define PG8_LAS __attribute__((address_space(3)))
typedef unsigned short bf16_t;
typedef short bf16x8 __attribute__((ext_vector_type(8)));
typedef float f32x4 __attribute__((ext_vector_type(4)));
typedef unsigned u32x4 __attribute__((ext_vector_type(4)));
constexpr int BM = 256, BK = 64, HALF = 128, HTB = HALF * BK * 2  , STAGE_BYTES = 8 * HTB, NXCD = 8, WGM = 8;

__host__ __device__ __forceinline__ int lds_byte(int r, int c) { const int st = (r >> 4) * 2 + (c >> 5), rr = r & 15, cc = c & 31, ob = rr * 64 + cc * 2; return st * 1024 + (ob ^ (((ob >> 9) & 1) << 5)); }
__host__ __device__ __forceinline__ void stage_rc(int b, int& R, int& C) { const int st = b / 1024, sb = b % 1024, swz = sb ^ (((sb >> 9) & 1) << 5); R = (st >> 1) * 16 + swz / 64; C = (st & 1) * 32 + (swz % 64) / 2; }
__host__ __device__ __forceinline__ int perm32(int rho) { const int n = rho >> 4, i = rho & 15; return 8 * (i >> 2) + 4 * n + (i & 3); }

struct Unit { int pm, pn; };
struct Gemm { const bf16_t* A; const bf16_t* Bt; int M, N, K; };

struct StaticOrder {
    int nM, nN, nwg, G, c;
    __host__ __device__ void init(int M, int N, int G_, int c_) { nM = M / BM; nN = N / BM; nwg = nM * nN; G = G_; c = c_; }
    __host__ __device__ bool next(int i, Unit& u) const {
        const long L = (long)i * G + c; if (L >= nwg) return false;
        int wgid = (int)L; { const int q = nwg / NXCD, r = nwg % NXCD, xcd = wgid % NXCD, off = wgid / NXCD; wgid = (xcd < r ? xcd * (q + 1) : r * (q + 1) + (xcd - r) * q) + off; }
        const int nig = WGM * nN, gid = wgid / nig, fm = gid * WGM, gsz = (nM - fm) < WGM ? (nM - fm) : WGM;
        u.pm = fm + ((wgid % nig) % gsz); u.pn = (wgid % nig) / gsz; return true;
    }
    __device__ __forceinline__ void a_ready(const Unit&) const {}
    __device__ __forceinline__ void done(const Unit&) const {}
};


__device__ __forceinline__ unsigned cvt_pk_bf16(float lo, float hi) { unsigned r; asm volatile("v_cvt_pk_bf16_f32 %0, %1, %2" : "=v"(r) : "v"(lo), "v"(hi)); return r; }

template <int ACT, bool RS, bool LPERM> struct EpiScale {
    static constexpr bool PERM = true, AFTER_DRAIN = false; static constexpr int NPART = 16;
    bf16_t* O; int ldc; const float* rowss; PG8_LAS unsigned char* scr; int fast_pm;
    __device__ __forceinline__ void operator()(const f32x4 (&acc)[2][2][4][2], const Unit& u, int wr, int wc, int fr, int fq) const {
        const int row0 = u.pm * BM + wr * 64 + fr, col0 = u.pn * BM + wc * 32 + 8 * fq;
        const int lane_ = fq * 16 + fr; PG8_LAS unsigned char* ws_ = scr + (wr * 4 + wc) * 1280;
        const int woff = fr * 80 + fq * 16, roff = (lane_ >> 2) * 80 + (lane_ & 3) * 16;
        const int srow0 = u.pm * BM + wr * 64 + (lane_ >> 2), scol0 = u.pn * BM + wc * 32 + 8 * (lane_ & 3);
        float part[8];
        if (!RS) {
#pragma unroll
            for (int k = 0; k < 8; ++k) part[k] = 0.f;
        } else if (u.pm < fast_pm) {
#pragma unroll
            for (int k = 0; k < 8; ++k) part[k] = rowss[(size_t)(row0 + (k >> 2) * HALF + (k & 3) * 16) * 16 + fq];
        } else {
#pragma unroll
            for (int k = 0; k < 8; ++k) { const f32x4 a = *(const f32x4*)(rowss + (size_t)(row0 + (k >> 2) * HALF + (k & 3) * 16) * 16 + 4 * fq); part[k] = (a[0] + a[1]) + (a[2] + a[3]); }
        }
        __builtin_amdgcn_sched_barrier(0);
#pragma unroll
        for (int ai = 0; ai < 2; ++ai)
#pragma unroll
            for (int m = 0; m < 4; ++m) {
                float rs = 1.0f;
                if (RS) { float ssum = part[ai * 4 + m]; ssum += __shfl_xor(ssum, 16); ssum += __shfl_xor(ssum, 32);
                    rs = __builtin_amdgcn_rsqf(ssum * (1.0f / 1024.0f) + 1e-6f); }
#pragma unroll
                for (int bj = 0; bj < 2; ++bj) {
                    f32x4 v0 = acc[ai][bj][m][0], v1 = acc[ai][bj][m][1];
                    if (RS) { v0 = v0 * rs; v1 = v1 * rs; }
                    if (ACT == 2) {
#pragma unroll
                        for (int e = 0; e < 4; ++e) { float a = fmaxf(v0[e], 0.f), b = fmaxf(v1[e], 0.f); v0[e] = a * a; v1[e] = b * b; }
                    }
                    u32x4 w; w.x = cvt_pk_bf16(v0[0], v0[1]); w.y = cvt_pk_bf16(v0[2], v0[3]); w.z = cvt_pk_bf16(v1[0], v1[1]); w.w = cvt_pk_bf16(v1[2], v1[3]);
                    if (LPERM) { *(PG8_LAS u32x4*)(ws_ + woff) = w;
                        const u32x4 w2 = *(const PG8_LAS u32x4*)(ws_ + roff);
                        *(u32x4*)(O + (size_t)(srow0 + ai * HALF + m * 16) * ldc + scol0 + bj * HALF) = w2; }
                    else *(u32x4*)(O + (size_t)(row0 + ai * HALF + m * 16) * ldc + col0 + bj * HALF) = w;
                }
            }
    }
};
struct EpiScaleF32 {
    static constexpr bool PERM = true, AFTER_DRAIN = false;
    float* O; int ldc; const float* rowss;
    __device__ __forceinline__ void operator()(const f32x4 (&acc)[2][2][4][2], const Unit& u, int wr, int wc, int fr, int fq) const {
        const int row0 = u.pm * BM + wr * 64 + fr, col0 = u.pn * BM + wc * 32 + 8 * fq;
#pragma unroll
        for (int ai = 0; ai < 2; ++ai)
#pragma unroll
            for (int m = 0; m < 4; ++m) {
                const int row = row0 + ai * HALF + m * 16;
                const float rs = __builtin_amdgcn_rsqf(rowss[row] * (1.0f / 1024.0f) + 1e-6f);
                float* rowp = O + (size_t)row * ldc + col0;
#pragma unroll
                for (int bj = 0; bj < 2; ++bj) {
                    *(f32x4*)(rowp + bj * HALF) = acc[ai][bj][m][0] * rs;
                    *(f32x4*)(rowp + bj * HALF + 4) = acc[ai][bj][m][1] * rs;
                }
            }
    }
};
struct EpiRes {
    static constexpr bool PERM = true, AFTER_DRAIN = false;
    float* Y; bf16_t* XB; float* ss; const float* sc;
    __device__ __forceinline__ void operator()(const f32x4 (&acc)[2][2][4][2], const Unit& u, int wr, int wc, int fr, int fq) const {
        const int row0 = u.pm * BM + wr * 64 + fr, col0 = u.pn * BM + wc * 32 + 8 * fq;
#pragma unroll
        for (int ai = 0; ai < 2; ++ai)
#pragma unroll
            for (int m = 0; m < 4; ++m) {
                const int row = row0 + ai * HALF + m * 16;
                bf16_t* bp = XB + (size_t)row * 1024 + col0;
                float s = 0.f, rs2 = 1.0f;
                if (sc) { const f32x4 a = *(const f32x4*)(sc + (size_t)row * 16 + 4 * fq); float t = (a[0] + a[1]) + (a[2] + a[3]); t += __shfl_xor(t, 16); t += __shfl_xor(t, 32); rs2 = __builtin_amdgcn_rcpf(t * (1.0f / 1024.0f) + 1e-6f); }
#pragma unroll
                for (int bj = 0; bj < 2; ++bj) {
                    const u32x4 xw = *(const u32x4*)(bp + bj * HALF);
                    f32x4 v0 = (f32x4){__builtin_bit_cast(float, xw.x << 16), __builtin_bit_cast(float, xw.x & 0xffff0000u), __builtin_bit_cast(float, xw.y << 16), __builtin_bit_cast(float, xw.y & 0xffff0000u)} + acc[ai][bj][m][0] * rs2;
                    f32x4 v1 = (f32x4){__builtin_bit_cast(float, xw.z << 16), __builtin_bit_cast(float, xw.z & 0xffff0000u), __builtin_bit_cast(float, xw.w << 16), __builtin_bit_cast(float, xw.w & 0xffff0000u)} + acc[ai][bj][m][1] * rs2;
                    if (Y) { float* yp = Y + (size_t)row * 1024 + col0 + bj * HALF; *(f32x4*)yp = v0; *(f32x4*)(yp + 4) = v1; }
                    s += (v0[0] * v0[0] + v0[1] * v0[1]) + (v0[2] * v0[2] + v0[3] * v0[3]) + (v1[0] * v1[0] + v1[1] * v1[1]) + (v1[2] * v1[2] + v1[3] * v1[3]);
                    u32x4 w; w.x = cvt_pk_bf16(v0[0], v0[1]); w.y = cvt_pk_bf16(v0[2], v0[3]); w.z = cvt_pk_bf16(v1[0], v1[1]); w.w = cvt_pk_bf16(v1[2], v1[3]);
                    *(u32x4*)(bp + bj * HALF) = w;
                }
                s += __shfl_xor(s, 16); s += __shfl_xor(s, 32);
                if (fq == 0) ss[(size_t)row * 16 + u.pn * 4 + wc] = s;
            }
    }
};

struct EpiResT {
    static constexpr bool PERM = true, AFTER_DRAIN = true;
    float* Y; bf16_t* XB; float* ss; const float* sc;
    __device__ __forceinline__ void fused(f32x4 (&acc)[2][2][4][2], const Unit& u, int wr, int wc, int fr, int fq, PG8_LAS unsigned char* lds, int wid, int lane) const {
        constexpr int LDQ = 260;
        typedef unsigned u32x2_t __attribute__((ext_vector_type(2)));
        PG8_LAS float* Q = (PG8_LAS float*)lds;
        const int col = u.pn * BM + 4 * lane;
        u32x2_t xv[8]; f32x4 pv[8];
#define RT_ROW(q, i) (u.pm * BM + 128 * ((q) >> 1) + 64 * ((wid * 8 + (i)) >> 5) + 32 * ((q) & 1) + ((wid * 8 + (i)) & 31))
#pragma unroll
        for (int i = 0; i < 8; ++i) { xv[i] = *(const u32x2_t*)(XB + (size_t)RT_ROW(0, i) * 1024 + col); pv[i] = sc ? *(const f32x4*)(sc + (size_t)RT_ROW(0, i) * 16) : (f32x4){0.f, 0.f, 0.f, 0.f}; }
#pragma unroll
        for (int q = 0; q < 4; ++q) {
            const int ai = q >> 1, mh = q & 1;
#pragma unroll
            for (int mm = 0; mm < 2; ++mm)
#pragma unroll
                for (int bj = 0; bj < 2; ++bj)
#pragma unroll
                    for (int n = 0; n < 2; ++n)
                        *(PG8_LAS f32x4*)(Q + (32 * wr + 16 * mm + fr) * LDQ + 128 * bj + 32 * wc + 8 * fq + 4 * n) = acc[ai][bj][2 * mh + mm][n];
            asm volatile("s_waitcnt lgkmcnt(0)" ::: "memory"); __builtin_amdgcn_s_barrier(); asm volatile("" ::: "memory");
            f32x4 v[8];
#pragma unroll
            for (int i = 0; i < 8; ++i) v[i] = *(const PG8_LAS f32x4*)(Q + (wid * 8 + i) * LDQ + 4 * lane);
            asm volatile("s_waitcnt lgkmcnt(0)" ::: "memory"); __builtin_amdgcn_s_barrier(); asm volatile("" ::: "memory");
#pragma unroll
            for (int i = 0; i < 8; ++i) v[i] = v[i] * (sc ? __builtin_amdgcn_rcpf(((pv[i][0] + pv[i][1]) + (pv[i][2] + pv[i][3])) * (1.0f / 1024.0f) + 1e-6f) : 1.0f) + (f32x4){__builtin_bit_cast(float, xv[i].x << 16), __builtin_bit_cast(float, xv[i].x & 0xffff0000u), __builtin_bit_cast(float, xv[i].y << 16), __builtin_bit_cast(float, xv[i].y & 0xffff0000u)};
            if (q < 3) {
#pragma unroll
                for (int i = 0; i < 8; ++i) { xv[i] = *(const u32x2_t*)(XB + (size_t)RT_ROW(q + 1, i) * 1024 + col); if (sc) pv[i] = *(const f32x4*)(sc + (size_t)RT_ROW(q + 1, i) * 16); }
            }
#pragma unroll
            for (int i = 0; i < 8; ++i) {
                const int row = RT_ROW(q, i);
                if (Y) *(f32x4*)(Y + (size_t)row * 1024 + col) = v[i];
                u32x2_t w; w.x = cvt_pk_bf16(v[i][0], v[i][1]); w.y = cvt_pk_bf16(v[i][2], v[i][3]);
                *(u32x2_t*)(XB + (size_t)row * 1024 + col) = w;
                float s = (v[i][0] * v[i][0] + v[i][1] * v[i][1]) + (v[i][2] * v[i][2] + v[i][3] * v[i][3]);
#pragma unroll
                for (int o = 1; o < 64; o <<= 1) s += __shfl_xor(s, o);
                if (lane == 0) ss[(size_t)row * 16 + u.pn] = s;
            }
        }
#undef RT_ROW
    }
};


template <class Epi, class Sched, bool ALIGN_EPI = false, bool SP2 = false>
__device__ __forceinline__ void gemm_phase(PG8_LAS unsigned char* lds, const Gemm g, const Sched& S, const Epi& E) {
    int tid_l = threadIdx.x; asm volatile("" : "+v"(tid_l));
    const int tid = tid_l, wid = __builtin_amdgcn_readfirstlane(tid >> 6), lane = tid & 63, wr = wid >> 2, wc = wid & 3, fr = lane & 15, fq = lane >> 4;
    const int K = g.K, nt = K / BK;
    unsigned voffA[2], voffB[2];
#pragma unroll
    for (int i = 0; i < 2; ++i) { int R, C; stage_rc(tid * 16 + i * 8192, R, C); const int Rb = Epi::PERM ? ((R & ~31) + perm32(R & 31)) : R;
        voffA[i] = (unsigned)(R * K + C) * 2u; voffB[i] = (unsigned)(Rb * K + C) * 2u; }
    const size_t kstep = (size_t)(BK * 2);
    const size_t hstep = (size_t)HALF * K * 2;
    const size_t tstep = 2 * hstep;
    const unsigned ldsw = (unsigned)wid * 1024u;
    const int aoff = lds_byte(wr * 64 + fr, fq * 8), boff = lds_byte(wc * 32 + fr, fq * 8);
#define PG8_SA(b, h) (((b) * 2 + (h)) * HTB)
#define PG8_SB(b, h) ((4 + (b) * 2 + (h)) * HTB)
#define PG8_STAGE(bufoff, gbase, voff) do { _Pragma("unroll") for (int _i = 0; _i < 2; ++_i) \
        __builtin_amdgcn_global_load_lds((const unsigned*)((const char*)(gbase) + (voff)[_i]), (PG8_LAS unsigned*)(lds + (bufoff) + ldsw + _i * 8192), 16, 0, 0); } while (0)
#define PG8_LDA(dst, b, h) do { _Pragma("unroll") for (int m = 0; m < 4; ++m) _Pragma("unroll") for (int k = 0; k < 2; ++k) dst[m][k] = *(const PG8_LAS bf16x8*)(lds + PG8_SA(b, h) + aoff + m * 2048 + k * 1024); } while (0)
#define PG8_LDB(dst, b, h) do { _Pragma("unroll") for (int n = 0; n < 2; ++n) _Pragma("unroll") for (int k = 0; k < 2; ++k) dst[n][k] = *(const PG8_LAS bf16x8*)(lds + PG8_SB(b, h) + boff + n * 2048 + k * 1024); } while (0)
#define PG8_MMA(ai, bj, At, Bt) do { __builtin_amdgcn_s_setprio(1); _Pragma("unroll") for (int m = 0; m < 4; ++m) _Pragma("unroll") for (int n = 0; n < 2; ++n) _Pragma("unroll") for (int k = 0; k < 2; ++k) \
        acc[ai][bj][m][n] = __builtin_amdgcn_mfma_f32_16x16x32_bf16(Bt[n][k], At[m][k], acc[ai][bj][m][n], 0, 0, 0); __builtin_amdgcn_s_setprio(0); } while (0)
#define PG8_WAIT_V(n) asm volatile("s_waitcnt vmcnt(" #n ")" ::: "memory")
#define PG8_WAIT_L(n) asm volatile("s_waitcnt lgkmcnt(" #n ")" ::: "memory")
#define PG8_BAR __builtin_amdgcn_s_barrier()
#define PG8_SCHED __builtin_amdgcn_sched_barrier(0)
    Unit cur, nxt; int ui = 0;
    if (!S.next(0, cur)) return;
    f32x4 acc[2][2][4][2];
#pragma unroll
    for (int a = 0; a < 2; ++a)
#pragma unroll
        for (int b = 0; b < 2; ++b)
#pragma unroll
            for (int m = 0; m < 4; ++m)
#pragma unroll
                for (int n = 0; n < 2; ++n) acc[a][b][m][n] = (f32x4){0.f, 0.f, 0.f, 0.f};
    bf16x8 At[4][2], B0[2][2], B1[2][2];
    const char* cA = (const char*)g.A + (size_t)cur.pm * tstep; const char* cB = (const char*)g.Bt + (size_t)cur.pn * tstep;
    S.a_ready(cur);
    if constexpr (SP2) {
        PG8_STAGE(PG8_SB(0, 0), cB, voffB); PG8_STAGE(PG8_SB(0, 1), cB + hstep, voffB); PG8_STAGE(PG8_SA(0, 0), cA, voffA); PG8_STAGE(PG8_SA(0, 1), cA + hstep, voffA);
        if (wr == 1) PG8_BAR;
        PG8_WAIT_V(2); PG8_BAR;
        PG8_STAGE(PG8_SB(1, 0), cB + kstep, voffB); PG8_STAGE(PG8_SA(1, 0), cA + kstep, voffA); PG8_STAGE(PG8_SB(1, 1), cB + hstep + kstep, voffB);
        PG8_WAIT_V(6); PG8_BAR;
    } else {
        PG8_STAGE(PG8_SB(0, 0), cB, voffB); PG8_STAGE(PG8_SA(0, 0), cA, voffA); PG8_STAGE(PG8_SB(0, 1), cB + hstep, voffB); PG8_STAGE(PG8_SA(0, 1), cA + hstep, voffA);
        if (wr == 1) PG8_BAR;
        PG8_WAIT_V(4); PG8_BAR;
        PG8_STAGE(PG8_SB(1, 0), cB + kstep, voffB); PG8_STAGE(PG8_SA(1, 0), cA + kstep, voffA); PG8_STAGE(PG8_SB(1, 1), cB + hstep + kstep, voffB);
        PG8_WAIT_V(6); PG8_BAR;
    }
    for (;;) {
        const bool has_next = S.next(ui + 1, nxt);
        const char* nA = has_next ? (const char*)g.A + (size_t)nxt.pm * tstep : cA; const char* nB = has_next ? (const char*)g.Bt + (size_t)nxt.pn * tstep : cB;
        for (int t = 0; t < nt; t += 2) {
            const bool last = (t == nt - 2);
            const char* a1 = cA + (size_t)(t + 1) * kstep;
            const char* a2 = last ? nA : cA + (size_t)(t + 2) * kstep; const char* b2 = last ? nB : cB + (size_t)(t + 2) * kstep;
            const char* a3 = a2 + kstep; const char* b3 = b2 + kstep;
            if (last && has_next) S.a_ready(nxt);
            if constexpr (SP2) {
            PG8_LDB(B0, 0, 0); PG8_LDB(B1, 0, 1); PG8_SCHED; PG8_LDA(At, 0, 0); PG8_STAGE(PG8_SA(1, 1), a1 + hstep, voffA);
            PG8_WAIT_V(8); PG8_WAIT_L(0); PG8_BAR; PG8_MMA(0, 0, At, B0); PG8_MMA(0, 1, At, B1); PG8_BAR; PG8_SCHED;
            PG8_LDA(At, 0, 1); PG8_STAGE(PG8_SB(0, 0), b2, voffB); PG8_STAGE(PG8_SB(0, 1), b2 + hstep, voffB); PG8_STAGE(PG8_SA(0, 0), a2, voffA);
            PG8_WAIT_V(8); PG8_WAIT_L(0); PG8_BAR; PG8_MMA(1, 0, At, B0); PG8_MMA(1, 1, At, B1); PG8_BAR; PG8_SCHED;
            PG8_LDB(B0, 1, 0); PG8_LDB(B1, 1, 1); PG8_SCHED; PG8_LDA(At, 1, 0); PG8_STAGE(PG8_SA(0, 1), a2 + hstep, voffA);
            PG8_WAIT_V(8); PG8_WAIT_L(0); PG8_BAR; PG8_MMA(0, 0, At, B0); PG8_MMA(0, 1, At, B1); PG8_BAR; PG8_SCHED;
            PG8_LDA(At, 1, 1); PG8_STAGE(PG8_SB(1, 0), b3, voffB); PG8_STAGE(PG8_SB(1, 1), b3 + hstep, voffB); PG8_STAGE(PG8_SA(1, 0), a3, voffA);
            PG8_WAIT_V(8); PG8_WAIT_L(0); PG8_BAR; PG8_MMA(1, 0, At, B0); PG8_MMA(1, 1, At, B1); PG8_BAR; PG8_SCHED;
            } else {
            PG8_LDB(B0, 0, 0); PG8_SCHED; PG8_LDA(At, 0, 0); PG8_STAGE(PG8_SA(1, 1), a1 + hstep, voffA);
            PG8_WAIT_L(8); PG8_BAR; PG8_WAIT_L(0); PG8_MMA(0, 0, At, B0); PG8_BAR; PG8_SCHED;
            PG8_LDB(B1, 0, 1); PG8_STAGE(PG8_SB(0, 0), b2, voffB);
            PG8_BAR; PG8_WAIT_L(0); PG8_MMA(0, 1, At, B1); PG8_BAR;
            PG8_LDA(At, 0, 1); PG8_STAGE(PG8_SA(0, 0), a2, voffA);
            PG8_BAR; PG8_WAIT_L(0); PG8_MMA(1, 0, At, B0); PG8_BAR; PG8_SCHED;
            PG8_STAGE(PG8_SB(0, 1), b2 + hstep, voffB);
            PG8_WAIT_V(6); PG8_BAR; PG8_MMA(1, 1, At, B1); PG8_BAR;
            PG8_LDB(B0, 1, 0); PG8_SCHED; PG8_LDA(At, 1, 0); PG8_STAGE(PG8_SA(0, 1), a2 + hstep, voffA);
            PG8_WAIT_L(8); PG8_BAR; PG8_WAIT_L(0); PG8_MMA(0, 0, At, B0); PG8_BAR; PG8_SCHED;
            PG8_LDB(B1, 1, 1); PG8_STAGE(PG8_SB(1, 0), b3, voffB);
            PG8_BAR; PG8_WAIT_L(0); PG8_MMA(0, 1, At, B1); PG8_BAR;
            PG8_LDA(At, 1, 1); PG8_STAGE(PG8_SA(1, 0), a3, voffA);
            PG8_BAR; PG8_WAIT_L(0); PG8_MMA(1, 0, At, B0); PG8_BAR; PG8_SCHED;
            PG8_STAGE(PG8_SB(1, 1), b3 + hstep, voffB);
            PG8_WAIT_V(6); PG8_BAR; PG8_MMA(1, 1, At, B1); PG8_BAR;
            }
        }
        if constexpr (ALIGN_EPI) { if (wr == 0) PG8_BAR; }
        if constexpr (!Epi::AFTER_DRAIN) { E(acc, cur, wr, wc, fr, fq); S.done(cur); }
        if (!has_next) break;
#pragma unroll
        for (int a = 0; a < 2; ++a)
#pragma unroll
            for (int b = 0; b < 2; ++b)
#pragma unroll
                for (int m = 0; m < 4; ++m)
#pragma unroll
                    for (int n = 0; n < 2; ++n) acc[a][b][m][n] = (f32x4){0.f, 0.f, 0.f, 0.f};
        cur = nxt; cA = nA; cB = nB; ++ui;
        if constexpr (ALIGN_EPI) { if (wr == 1) PG8_BAR; }
    }
    PG8_WAIT_V(0);
    if constexpr (!ALIGN_EPI) { if (wr == 0) PG8_BAR; }
    PG8_BAR;
    if constexpr (Epi::AFTER_DRAIN) { E.fused(acc, cur, wr, wc, fr, fq, lds, wid, lane); S.done(cur); }
#undef PG8_SA
#undef PG8_SB
#undef PG8_STAGE
#undef PG8_LDA
#undef PG8_LDB
#undef PG8_MMA
#undef PG8_WAIT_V
#undef PG8_WAIT_L
#undef PG8_BAR
#undef PG8_SCHED
}
}

constexpr int D = 1024, NB = 8, T = 2048, MP = NB * T, NS = 128, TS = 4, MS = NS * TS, M = MP + MS;
constexpr int HD = 64, NQ = 12, NKV = 4, WIN = 128, NMEM = 256, NXH = 4, FF = 4096, DEPTH = 4;
constexpr int ATT_IN = 1536, CONV_IN = 2560, CONV_CH = 768, MEMROWS = NB * NMEM;
constexpr int NWAVES = 8, NTHR = 512;
constexpr int LDS_BYTES = 147456;
constexpr int NPH = 1 + 5 * DEPTH;
constexpr size_t MiB = 1u << 20;
constexpr size_t WS_BAR = 0;
constexpr size_t WS_MEMSS = 1 * MiB;
constexpr size_t WS_ROPE = 2 * MiB;
constexpr size_t WS_WINA = 4 * MiB;
constexpr size_t WS_WINC = 10 * MiB;
constexpr size_t WS_WMEM = 20 * MiB;
constexpr size_t WS_WOUT = 24 * MiB;
constexpr size_t WS_WUP = 32 * MiB;
constexpr size_t WS_WDN = 64 * MiB;
constexpr size_t WS_MEMB = 96 * MiB;
constexpr size_t WS_MEMRAW = 100 * MiB;
constexpr size_t WS_XB = 116 * MiB;
constexpr size_t WS_OB = 150 * MiB;
constexpr size_t WS_Z = 184 * MiB;
constexpr size_t WS_ACT = 268 * MiB;
constexpr size_t WS_ROWSS = 401 * MiB;
constexpr size_t WS_END = 411 * MiB;
static_assert(WS_XB + (size_t)M * D * 2 <= WS_OB && WS_OB + (size_t)M * D * 2 <= WS_Z && WS_Z + (size_t)M * CONV_IN * 2 <= WS_ACT && WS_ACT + (size_t)M * FF * 2 <= WS_END, "ws map");
constexpr size_t O_Y = 0;
constexpr size_t O_SWAK_P = (size_t)M * D;
constexpr size_t O_SWAV_P = O_SWAK_P + (size_t)2 * NB * WIN * NKV * HD;
constexpr size_t O_CONV_P = O_SWAV_P + (size_t)2 * NB * WIN * NKV * HD;
constexpr size_t O_MEMK_P = O_CONV_P + (size_t)2 * NB * 2 * CONV_CH;
constexpr size_t O_MEMV_P = O_MEMK_P + (size_t)DEPTH * NB * NMEM * NXH * HD;
constexpr size_t O_SWAK_S = O_MEMV_P + (size_t)DEPTH * NB * NMEM * NXH * HD;
constexpr size_t O_SWAV_S = O_SWAK_S + (size_t)2 * NS * WIN * NKV * HD;
constexpr size_t O_CONV_S = O_SWAV_S + (size_t)2 * NS * WIN * NKV * HD;
constexpr size_t O_END = O_CONV_S + (size_t)2 * NS * 2 * CONV_CH;

#define LAS __attribute__((address_space(3)))
typedef unsigned short bf16;
typedef short bf16x8 __attribute__((ext_vector_type(8)));
typedef float f32x4 __attribute__((ext_vector_type(4)));
typedef unsigned u32x4 __attribute__((ext_vector_type(4)));
typedef unsigned u32x2 __attribute__((ext_vector_type(2)));
#define LDS_WAIT() asm volatile("s_waitcnt lgkmcnt(0)" ::: "memory")

__device__ __forceinline__ unsigned f2bf(float f) { unsigned u = __builtin_bit_cast(unsigned, f); return (u + 0x7fffu + ((u >> 16) & 1u)) >> 16; }
__device__ __forceinline__ unsigned pk2(float lo, float hi) { return pg8::cvt_pk_bf16(lo, hi); }
__device__ __forceinline__ float bflo(unsigned w) { return __builtin_bit_cast(float, w << 16); }
__device__ __forceinline__ float bfhi(unsigned w) { return __builtin_bit_cast(float, w & 0xffff0000u); }
__device__ __forceinline__ float wave_sum(float v) {
#pragma unroll
    for (int o = 1; o < 64; o <<= 1) v += __shfl_xor(v, o);
    return v;
}

struct Args {
    const float* in[23]; float* out; unsigned char* ws; int ph_lo, ph_hi;
};

constexpr int SCR_WAVE_BYTES = 64 * 65 * 4;
__device__ __forceinline__ void p0_transpose_item(const float* W, int K, int N, bf16* WT, const float* gain, LAS float* scr, int item, int lane) {
    const int nblk = N / 64, kb = item / nblk, nb = item % nblk, k0 = 64 * kb, n0 = 64 * nb;
    const int kl = lane >> 4, nl = 4 * (lane & 15);
    f32x4 w[16];
#pragma unroll
    for (int i = 0; i < 16; ++i) w[i] = *(const f32x4*)(W + (size_t)(k0 + kl + 4 * i) * N + n0 + nl);
    if (gain) {
#pragma unroll
        for (int i = 0; i < 16; ++i) w[i] = w[i] * gain[k0 + kl + 4 * i];
    }
#pragma unroll
    for (int i = 0; i < 16; ++i) { LAS float* d = scr + (kl + 4 * i) * 65 + nl; d[0] = w[i].x; d[1] = w[i].y; d[2] = w[i].z; d[3] = w[i].w; }
    LDS_WAIT(); asm volatile("" ::: "memory");
    const int c = lane & 7;
#pragma unroll
    for (int j = 0; j < 8; ++j) { const int n = (lane >> 3) + 8 * j; const LAS float* s = scr + (8 * c) * 65 + n;
        u32x4 o; o.x = pk2(s[0 * 65], s[1 * 65]); o.y = pk2(s[2 * 65], s[3 * 65]); o.z = pk2(s[4 * 65], s[5 * 65]); o.w = pk2(s[6 * 65], s[7 * 65]);
        *(u32x4*)(WT + (size_t)(n0 + n) * K + k0 + 8 * c) = o; }
    LDS_WAIT(); asm volatile("" ::: "memory");
}
__device__ __forceinline__ float row_to_bf16(const float* xrow, bf16* orow, float* crow, int lane) {
    const f32x4* xr = (const f32x4*)xrow + lane; float s = 0.f;
    f32x4 v[4];
#pragma unroll
    for (int j = 0; j < 4; ++j) { v[j] = xr[64 * j]; s += (v[j].x * v[j].x + v[j].y * v[j].y) + (v[j].z * v[j].z + v[j].w * v[j].w); }
    u32x2* o8 = (u32x2*)orow + lane;
#pragma unroll
    for (int j = 0; j < 4; ++j) { u32x2 w; w.x = pk2(v[j].x, v[j].y); w.y = pk2(v[j].z, v[j].w); o8[64 * j] = w; }
    if (crow) { f32x4* c = (f32x4*)crow + lane;
#pragma unroll
        for (int j = 0; j < 4; ++j) c[64 * j] = v[j]; }
    return wave_sum(s);
}
__device__ const double INV_FREQ[32] = {1.0, 0.7498942093324558, 0.5623413251903491, 0.4216965034285822, 0.3162277660168379, 0.23713737056616546, 0.17782794100389226, 0.1333521432163324,
    0.09999999999999998, 0.07498942093324555, 0.056234132519034884, 0.04216965034285822, 0.031622776601683784, 0.02371373705661654, 0.017782794100389226, 0.01333521432163323,
    0.009999999999999995, 0.007498942093324557, 0.005623413251903487, 0.004216965034285821, 0.0031622776601683764, 0.0023713737056616536, 0.001778279410038922, 0.0013335214321633228,
    0.0009999999999999994, 0.0007498942093324555, 0.0005623413251903486, 0.00042169650342858197, 0.00031622776601683783, 0.00023713737056616532, 0.00017782794100389203, 0.00013335214321633237};
__device__ __forceinline__ void sincos_d(double ang, float& c, float& s) {
    const double TWO_PI = 6.283185307179586476925286766559;
    const double k = __builtin_rint(ang * (1.0 / TWO_PI));
    const double r = ang - k * TWO_PI, r2 = r * r;
    double sn = 1.0, cs = 1.0;
#pragma unroll
    for (int n = 14; n >= 1; --n) { sn = 1.0 - sn * r2 * (1.0 / (double)((2 * n) * (2 * n + 1))); cs = 1.0 - cs * r2 * (1.0 / (double)((2 * n - 1) * (2 * n))); }
    s = (float)(sn * r); c = (float)cs;
}

constexpr int KS_STRIDE = 144, VT_STRIDE = 528, KS_OFF = 0, VT_OFF = 256 * KS_STRIDE;
template <bool F32> __device__ __forceinline__ void ld8(const void* p, float (&v)[8]) {
    if (F32) { const f32x4 a = ((const f32x4*)p)[0], b = ((const f32x4*)p)[1]; v[0] = a.x; v[1] = a.y; v[2] = a.z; v[3] = a.w; v[4] = b.x; v[5] = b.y; v[6] = b.z; v[7] = b.w; }
    else { const u32x4 w = *(const u32x4*)p; v[0] = bflo(w.x); v[1] = bfhi(w.x); v[2] = bflo(w.y); v[3] = bfhi(w.y); v[4] = bflo(w.z); v[5] = bfhi(w.z); v[6] = bflo(w.w); v[7] = bfhi(w.w); }
}
__device__ __forceinline__ void ld8f_nt(const float* p, float (&v)[8]) { const f32x4 a = __builtin_nontemporal_load((const f32x4*)p), b = __builtin_nontemporal_load((const f32x4*)p + 1);
    v[0] = a.x; v[1] = a.y; v[2] = a.z; v[3] = a.w; v[4] = b.x; v[5] = b.y; v[6] = b.z; v[7] = b.w; }
__device__ __forceinline__ void st8f_nt(float* p, const float (&v)[8]) { __builtin_nontemporal_store((f32x4){v[0], v[1], v[2], v[3]}, (f32x4*)p); __builtin_nontemporal_store((f32x4){v[4], v[5], v[6], v[7]}, (f32x4*)p + 1); }
__device__ __forceinline__ void st8f(float* p, const float (&v)[8]) { ((f32x4*)p)[0] = (f32x4){v[0], v[1], v[2], v[3]}; ((f32x4*)p)[1] = (f32x4){v[4], v[5], v[6], v[7]}; }
__device__ __forceinline__ u32x4 pk8(const float (&v)[8]) { u32x4 w; w.x = pk2(v[0], v[1]); w.y = pk2(v[2], v[3]); w.z = pk2(v[4], v[5]); w.w = pk2(v[6], v[7]); return w; }
template <int X1, int X2, bool NORM, bool ROPE>
__device__ __forceinline__ void norm_rope16(float (&a)[8], float (&b)[8], int jq, const float* gain, const float* cs) {
    if (NORM) {
        float s = 0.f;
#pragma unroll
        for (int i = 0; i < 8; ++i) s += a[i] * a[i] + b[i] * b[i];
        s += __shfl_xor(s, X1); s += __shfl_xor(s, X2);
        const float r = __builtin_amdgcn_rsqf(s * (1.0f / 64.0f) + 1e-6f);
        float ga[8], gb[8]; ld8<true>(gain + 8 * jq, ga); ld8<true>(gain + 32 + 8 * jq, gb);
#pragma unroll
        for (int i = 0; i < 8; ++i) { a[i] = a[i] * r * ga[i]; b[i] = b[i] * r * gb[i]; }
    }
    if (ROPE) {
        float c[8], sn[8]; ld8<true>(cs + 8 * jq, c); ld8<true>(cs + 32 + 8 * jq, sn);
#pragma unroll
        for (int i = 0; i < 8; ++i) { const float x1 = a[i], x2 = b[i]; a[i] = x1 * c[i] - x2 * sn[i]; b[i] = x2 * c[i] + x1 * sn[i]; }
    }
}
template <bool F32, bool NORM, bool ROPE, bool NT = false>
__device__ __forceinline__ void stage_k(LAS unsigned char* Ks, int slot, int jq, const void* src, const float* gain, const float* cs, float* outf) {
    float a[8], b[8]; constexpr int ES = F32 ? 4 : 2;
    if (NT) { ld8f_nt((const float*)src + 8 * jq, a); ld8f_nt((const float*)src + 32 + 8 * jq, b); }
    else { ld8<F32>((const char*)src + 8 * jq * ES, a); ld8<F32>((const char*)src + (32 + 8 * jq) * ES, b); }
    norm_rope16<1, 2, NORM, ROPE>(a, b, jq, gain, cs);
    if (outf) { if (NT) { st8f_nt(outf + 8 * jq, a); st8f_nt(outf + 32 + 8 * jq, b); } else { st8f(outf + 8 * jq, a); st8f(outf + 32 + 8 * jq, b); } }
    *(LAS u32x4*)(Ks + slot * KS_STRIDE + 16 * jq) = pk8(a); *(LAS u32x4*)(Ks + slot * KS_STRIDE + 64 + 16 * jq) = pk8(b);
}
template <bool F32, bool NT = false>
__device__ __forceinline__ void stage_v(LAS unsigned char* Vt, int slot, int jq, const void* src, float* outf) {
    float a[8], b[8]; constexpr int ES = F32 ? 4 : 2;
    if (NT) { ld8f_nt((const float*)src + 16 * jq, a); ld8f_nt((const float*)src + 16 * jq + 8, b); }
    else { ld8<F32>((const char*)src + 16 * jq * ES, a); ld8<F32>((const char*)src + (16 * jq + 8) * ES, b); }
    if (outf) { if (NT) { st8f_nt(outf + 16 * jq, a); st8f_nt(outf + 16 * jq + 8, b); } else { st8f(outf + 16 * jq, a); st8f(outf + 16 * jq + 8, b); } }
#pragma unroll
    for (int i = 0; i < 8; ++i) { *(LAS bf16*)(Vt + (16 * jq + i) * VT_STRIDE + slot * 2) = (bf16)f2bf(a[i]); *(LAS bf16*)(Vt + (16 * jq + 8 + i) * VT_STRIDE + slot * 2) = (bf16)f2bf(b[i]); }
}
__device__ __forceinline__ void stage_zero(LAS unsigned char* Ks, LAS unsigned char* Vt, int slot, int jq) {
    *(LAS u32x4*)(Ks + slot * KS_STRIDE + 16 * jq) = (u32x4){0u, 0u, 0u, 0u}; *(LAS u32x4*)(Ks + slot * KS_STRIDE + 64 + 16 * jq) = (u32x4){0u, 0u, 0u, 0u};
#pragma unroll
    for (int i = 0; i < 16; ++i) *(LAS bf16*)(Vt + (16 * jq + i) * VT_STRIDE + slot * 2) = (bf16)0;
}
template <bool ROPE>
__device__ __forceinline__ void load_q(const bf16* src, int q4, const float* gain, const float* cs, bf16x8& f0, bf16x8& f1) {
    float a[8], b[8];
    ld8<false>(src + 8 * q4, a); ld8<false>(src + 32 + 8 * q4, b);
    norm_rope16<16, 32, true, ROPE>(a, b, q4, gain, cs);
#pragma unroll
    for (int i = 0; i < 8; ++i) { a[i] *= 0.18033688011112042f; b[i] *= 0.18033688011112042f; }
    f0 = __builtin_bit_cast(bf16x8, pk8(a)); f1 = __builtin_bit_cast(bf16x8, pk8(b));
}
template <int NT>
__device__ __forceinline__ void attn_rows16(const LAS unsigned char* Ks, const LAS unsigned char* Vt, int t0, bf16x8 q0, bf16x8 q1, int lo, int hi, float sink, bf16* outp, bool valid, int lane) {
    const int r16 = lane & 15, q4 = lane >> 4;
    f32x4 s[NT];
#pragma unroll
    for (int kt = 0; kt < NT; ++kt) {
        const LAS unsigned char* kp = Ks + (16 * (t0 + kt) + r16) * KS_STRIDE + 16 * q4;
        const bf16x8 k0 = *(const LAS bf16x8*)kp, k1 = *(const LAS bf16x8*)(kp + 64);
        f32x4 c = {0.f, 0.f, 0.f, 0.f};
        c = __builtin_amdgcn_mfma_f32_16x16x32_bf16(k0, q0, c, 0, 0, 0);
        c = __builtin_amdgcn_mfma_f32_16x16x32_bf16(k1, q1, c, 0, 0, 0);
        s[kt] = c;
    }
    sink *= 1.4426950408889634f;
    float m = sink;
#pragma unroll
    for (int kt = 0; kt < NT; ++kt)
#pragma unroll
        for (int i = 0; i < 4; ++i) { const int j = 16 * (t0 + kt) + 4 * q4 + i; const float v = (j >= lo && j <= hi) ? s[kt][i] : -1e30f; s[kt][i] = v; m = fmaxf(m, v); }
    m = fmaxf(m, __shfl_xor(m, 16)); m = fmaxf(m, __shfl_xor(m, 32));
    float sum = 0.f;
#pragma unroll
    for (int kt = 0; kt < NT; ++kt)
#pragma unroll
        for (int i = 0; i < 4; ++i) { const float p = __builtin_amdgcn_exp2f(s[kt][i] - m); s[kt][i] = p; sum += p; }
    sum += __shfl_xor(sum, 16); sum += __shfl_xor(sum, 32);
    sum += __builtin_amdgcn_exp2f(sink - m);
    const float inv = 1.0f / sum;
    f32x4 o[4];
#pragma unroll
    for (int dt = 0; dt < 4; ++dt) o[dt] = (f32x4){0.f, 0.f, 0.f, 0.f};
#pragma unroll
    for (int kb = 0; kb < NT / 2; ++kb) {
        u32x4 pw; pw.x = pk2(s[2 * kb][0], s[2 * kb][1]); pw.y = pk2(s[2 * kb][2], s[2 * kb][3]);
        pw.z = pk2(s[2 * kb + 1][0], s[2 * kb + 1][1]); pw.w = pk2(s[2 * kb + 1][2], s[2 * kb + 1][3]);
        const bf16x8 pf = __builtin_bit_cast(bf16x8, pw);
#pragma unroll
        for (int dt = 0; dt < 4; ++dt) {
            const LAS unsigned char* vp = Vt + (16 * dt + r16) * VT_STRIDE + (16 * (t0 + 2 * kb) + 4 * q4) * 2;
            const u32x2 v0 = *(const LAS u32x2*)vp, v1 = *(const LAS u32x2*)(vp + 32);
            const bf16x8 vf = __builtin_bit_cast(bf16x8, (u32x4){v0.x, v0.y, v1.x, v1.y});
            o[dt] = __builtin_amdgcn_mfma_f32_16x16x32_bf16(vf, pf, o[dt], 0, 0, 0);
        }
    }
    if (valid) {
#pragma unroll
        for (int dt = 0; dt < 4; ++dt) { u32x2 w; w.x = pk2(o[dt][0] * inv, o[dt][1] * inv); w.y = pk2(o[dt][2] * inv, o[dt][3] * inv); *(u32x2*)(outp + 16 * dt) = w; }
    }
}
#define XB_TMO      128
#define XB_XCNT(j)  (256  + 64 * (j))
#define XB_XSUB(j)  (1280 + 64 * (j))
#define XB_XGEN(j)  (2304 + 64 * (j))
#define XB_TOP      3328
#define XB_TOPGEN   3392
#define XCD_BAR_WORDS 3456
#define XB_SPIN_CAP (1u << 18)

__device__ __forceinline__ unsigned xb_ld(unsigned* p)              { return __hip_atomic_load(p, __ATOMIC_RELAXED, __HIP_MEMORY_SCOPE_AGENT); }
__device__ __forceinline__ unsigned xb_add(unsigned* p, unsigned v) { return __hip_atomic_fetch_add(p, v, __ATOMIC_RELAXED, __HIP_MEMORY_SCOPE_AGENT); }
__device__ __forceinline__ unsigned xb_xcc_id() { return (unsigned)__builtin_amdgcn_s_getreg((3 << 11) | 20) & 0xFu; }
#define XB_SPIN(cond, bar) do { unsigned _sp = 0; while (cond) { __builtin_amdgcn_s_sleep(1); \
    if ((++_sp & 255u) == 0u) { if (xb_ld(&(bar)[XB_TMO])) break; if (_sp > XB_SPIN_CAP) { atomicAdd(&(bar)[XB_TMO], 1u); break; } } } } while (0)

struct XcdBarrier {
    unsigned* bar; unsigned x;
    volatile LAS unsigned* st;
};

__device__ __forceinline__ XcdBarrier xcd_barrier_post(unsigned* bar, volatile LAS unsigned* st) {
    XcdBarrier b; b.bar = bar; b.x = xb_xcc_id(); b.st = st;
    if (threadIdx.x == 0) (void)xb_add(&bar[XB_XCNT(b.x)], 1u);
    return b;
}
__device__ __forceinline__ void xcd_barrier_complete(unsigned* bar, unsigned x, unsigned& nloc, unsigned& nx) {
    const unsigned G = gridDim.x * gridDim.y * gridDim.z;
    unsigned sum, cnt, mine, sp = 0u;
    for (;;) {
        sum = 0u; cnt = 0u; mine = 0u;
#pragma unroll
        for (unsigned j = 0; j < 16; ++j) { const unsigned c = xb_ld(&bar[XB_XCNT(j)]); sum += c; cnt += (c > 0u) ? 1u : 0u; mine = (j == x) ? c : mine; }
        if (sum == G) break;
        __builtin_amdgcn_s_sleep(1);
        if ((++sp & 255u) == 0u) { if (xb_ld(&bar[XB_TMO])) break; if (sp > XB_SPIN_CAP) { atomicAdd(&bar[XB_TMO], 1u); break; } }
    }
    nloc = mine > 0u ? mine : 1u; nx = cnt > 0u ? cnt : 1u;
}

__device__ __forceinline__ void xcd_barrier(const XcdBarrier& b) {
    asm volatile("s_waitcnt vmcnt(0)" ::: "memory");
    __syncthreads();
    if (threadIdx.x == 0) {
        unsigned* bar = b.bar;
        __builtin_amdgcn_s_waitcnt(0);
        unsigned nloc = b.st[0], nx = b.st[1];
        if (nloc == 0u) { xcd_barrier_complete(bar, b.x, nloc, nx); b.st[0] = nloc; b.st[1] = nx; }
        const unsigned old = xb_add(&bar[XB_XSUB(b.x)], 1u);
        const unsigned gen = old / nloc;
        if (old + 1u == (gen + 1u) * nloc) {
            __builtin_amdgcn_fence(__ATOMIC_RELEASE, "agent");
            asm volatile("s_waitcnt vmcnt(0)" ::: "memory");
            const unsigned og = xb_add(&bar[XB_TOP], 1u);
            const unsigned tg = og / nx;
            if (og + 1u == (tg + 1u) * nx) xb_add(&bar[XB_TOPGEN], 1u);
            else XB_SPIN(xb_ld(&bar[XB_TOPGEN]) == tg, bar);
            __builtin_amdgcn_fence(__ATOMIC_ACQUIRE, "agent");
            xb_add(&bar[XB_XGEN(b.x)], 1u);
            asm volatile("s_waitcnt vmcnt(0)" ::: "memory");
        } else {
            XB_SPIN(xb_ld(&bar[XB_XGEN(b.x)]) == gen, bar);
            __builtin_amdgcn_fence(__ATOMIC_ACQUIRE, "agent");
            asm volatile("s_waitcnt vmcnt(0)" ::: "memory");
        }
    }
    __syncthreads();
}


template <int ACT, bool RS> struct SkScale {
    bf16* O; int ldc; const float* rowss;
    __device__ __forceinline__ void apply(int row, int col, float (&v)[8], int tid) const {
        float rs = 1.0f;
        if (RS) { const f32x4* sp = (const f32x4*)(rowss + (size_t)row * 16); const f32x4 a = sp[0], b = sp[1], c = sp[2], d = sp[3];
            const float ssum = (((a[0] + a[1]) + (a[2] + a[3])) + ((b[0] + b[1]) + (b[2] + b[3]))) + (((c[0] + c[1]) + (c[2] + c[3])) + ((d[0] + d[1]) + (d[2] + d[3])));
            rs = __builtin_amdgcn_rsqf(ssum * (1.0f / 1024.0f) + 1e-6f); }
#pragma unroll
        for (int i = 0; i < 8; ++i) { float x = v[i] * rs; if (ACT == 2) { x = fmaxf(x, 0.f); x = x * x; } v[i] = x; }
        *(u32x4*)(O + (size_t)row * ldc + col) = pk8(v);
    }
};
struct SkRes {
    float* Y; bf16* XB; float* ss; const float* sc;
    __device__ __forceinline__ void apply(int row, int col, float (&v)[8], int tid) const {
        if (sc) { const f32x4* sp = (const f32x4*)(sc + (size_t)row * 16); const f32x4 a = sp[0], b = sp[1], c = sp[2], d = sp[3];
            const float ssum = (((a[0] + a[1]) + (a[2] + a[3])) + ((b[0] + b[1]) + (b[2] + b[3]))) + (((c[0] + c[1]) + (c[2] + c[3])) + ((d[0] + d[1]) + (d[2] + d[3])));
            const float rs2 = __builtin_amdgcn_rcpf(ssum * (1.0f / 1024.0f) + 1e-6f);
#pragma unroll
            for (int i = 0; i < 8; ++i) v[i] *= rs2; }
        bf16* bp = XB + (size_t)row * D + col; float x[8]; ld8<false>(bp, x); float s = 0.f;
#pragma unroll
        for (int i = 0; i < 8; ++i) { x[i] += v[i]; s += x[i] * x[i]; }
        if (Y) st8f(Y + (size_t)row * D + col, x);
        *(u32x4*)bp = pk8(x);
        s += __shfl_xor(s, 1); s += __shfl_xor(s, 2); s += __shfl_xor(s, 4);
        if ((tid & 7) == 0) ss[(size_t)row * 16 + (col >> 6)] = s;
    }
};
template <int NTW, int WN, int WK, class Epi>
__device__ __forceinline__ void skinny_unit(LAS unsigned char* lds, const bf16* A, const bf16* Bt, int K, int r0, int n0, const Epi& E, int tid) {
    constexpr int NC = 16 * NTW * WN, LDP = NC + 4;
    static_assert(WN * WK == NWAVES && WK * 32 * LDP * 4 <= 131072, "skinny layout");
    const int lane = tid & 63, wave = __builtin_amdgcn_readfirstlane(tid >> 6), wn = wave % WN, wk = wave / WN;
    const int r16 = lane & 15, q4 = lane >> 4;
    const int KW = K / WK;
    const bf16* ap = A + (size_t)(r0 + (lane >> 2)) * K + wk * KW + 8 * (lane & 3);
    const bf16* bp = Bt + (size_t)(n0 + wn * 16 * NTW + (lane >> 2)) * K + wk * KW + 8 * (lane & 3);
    constexpr int SLOT = 16 * 80, NSLOT = 2 * (2 + NTW);
    static_assert(NWAVES * NSLOT * SLOT <= 131072, "skinny permute scratch");
    LAS unsigned char* wsc = lds + wave * (NSLOT * SLOT);
    const int woff = (lane >> 2) * 80 + (lane & 3) * 16, roff = r16 * 80 + q4 * 16;
    f32x4 acc[2][NTW];
#pragma unroll
    for (int nt = 0; nt < NTW; ++nt) { acc[0][nt] = (f32x4){0.f, 0.f, 0.f, 0.f}; acc[1][nt] = (f32x4){0.f, 0.f, 0.f, 0.f}; }
    bf16x8 sa0[2][2], sb0[2][NTW], sa1[2][2], sb1[2][NTW];
#define SK_LOAD(sa, sb, kk) do { _Pragma("unroll") for (int u_ = 0; u_ < 2; ++u_) { sa[u_][0] = *(const bf16x8*)(ap + (kk) + 32 * u_); sa[u_][1] = *(const bf16x8*)(ap + (size_t)16 * K + (kk) + 32 * u_); \
        _Pragma("unroll") for (int nt = 0; nt < NTW; ++nt) sb[u_][nt] = *(const bf16x8*)(bp + (size_t)nt * 16 * K + (kk) + 32 * u_); } } while (0)
#define SK_PERM(sa, sb) do { _Pragma("unroll") for (int u_ = 0; u_ < 2; ++u_) { *(LAS bf16x8*)(wsc + (u_ * (2 + NTW) + 0) * SLOT + woff) = sa[u_][0]; *(LAS bf16x8*)(wsc + (u_ * (2 + NTW) + 1) * SLOT + woff) = sa[u_][1]; \
        _Pragma("unroll") for (int nt = 0; nt < NTW; ++nt) *(LAS bf16x8*)(wsc + (u_ * (2 + NTW) + 2 + nt) * SLOT + woff) = sb[u_][nt]; } \
        _Pragma("unroll") for (int u_ = 0; u_ < 2; ++u_) { sa[u_][0] = *(const LAS bf16x8*)(wsc + (u_ * (2 + NTW) + 0) * SLOT + roff); sa[u_][1] = *(const LAS bf16x8*)(wsc + (u_ * (2 + NTW) + 1) * SLOT + roff); \
        _Pragma("unroll") for (int nt = 0; nt < NTW; ++nt) sb[u_][nt] = *(const LAS bf16x8*)(wsc + (u_ * (2 + NTW) + 2 + nt) * SLOT + roff); } } while (0)
#define SK_MMA(sa, sb) do { _Pragma("unroll") for (int u_ = 0; u_ < 2; ++u_) _Pragma("unroll") for (int nt = 0; nt < NTW; ++nt) { \
        acc[0][nt] = __builtin_amdgcn_mfma_f32_16x16x32_bf16(sb[u_][nt], sa[u_][0], acc[0][nt], 0, 0, 0); acc[1][nt] = __builtin_amdgcn_mfma_f32_16x16x32_bf16(sb[u_][nt], sa[u_][1], acc[1][nt], 0, 0, 0); } } while (0)
    SK_LOAD(sa0, sb0, 0);
#pragma unroll 1
    for (int k = 0; k < KW; k += 128) {
        SK_LOAD(sa1, sb1, k + 64);
        __builtin_amdgcn_sched_barrier(0);
        SK_PERM(sa0, sb0); SK_MMA(sa0, sb0);
        __builtin_amdgcn_sched_barrier(0);
        if (k + 128 < KW) SK_LOAD(sa0, sb0, k + 128);
        __builtin_amdgcn_sched_barrier(0);
        SK_PERM(sa1, sb1); SK_MMA(sa1, sb1);
        __builtin_amdgcn_sched_barrier(0);
    }
#undef SK_LOAD
#undef SK_PERM
#undef SK_MMA
    __syncthreads();
    LAS float* P = (LAS float*)lds;
#pragma unroll
    for (int mt = 0; mt < 2; ++mt)
#pragma unroll
        for (int nt = 0; nt < NTW; ++nt) *(LAS f32x4*)(P + (wk * 32 + mt * 16 + r16) * LDP + wn * 16 * NTW + nt * 16 + 4 * q4) = acc[mt][nt];
    __syncthreads();
#pragma unroll 1
    for (int it = tid; it < 32 * (NC / 8); it += NTHR) {
        const int row = it / (NC / 8), c8 = (it % (NC / 8)) * 8;
        float v[8];
#pragma unroll
        for (int i = 0; i < 8; ++i) v[i] = 0.f;
#pragma unroll
        for (int w = 0; w < WK; ++w) { const LAS f32x4* pp = (const LAS f32x4*)(P + (w * 32 + row) * LDP + c8); const f32x4 x = pp[0], y = pp[1];
            v[0] += x[0]; v[1] += x[1]; v[2] += x[2]; v[3] += x[3]; v[4] += y[0]; v[5] += y[1]; v[6] += y[2]; v[7] += y[3]; }
        E.apply(r0 + row, n0 + c8, v, tid);
    }
    __syncthreads();
}
template <int NTW, int WN, int WK, class Epi>
__device__ __forceinline__ void skinny_gemm(LAS unsigned char* lds, const bf16* A, const bf16* Bt, int K, const Epi& E, int u0, int nu, int tid) {
    constexpr int NC = 16 * NTW * WN;
#pragma unroll 1
    for (int u = u0; u < u0 + nu; ++u) skinny_unit<NTW, WN, WK, Epi>(lds, A, Bt, K, MP + 32 * (u >> 4), NC * (u & 15), E, tid);
}

template <int PART>
__device__ __forceinline__ void item_swa_prompt(const Args& A, LAS unsigned char* lds, int it, int j, int tid, int wave, int lane) {
    const int qb = it & 15, g = (it >> 4) & 3, b = it >> 6;
    const bf16* Z = (const bf16*)(A.ws + WS_Z); bf16* OB = (bf16*)(A.ws + WS_OB); const float* rope = (const float*)(A.ws + WS_ROPE);
    LAS unsigned char* Ks = lds + KS_OFF; LAS unsigned char* Vt = lds + VT_OFF;
    const float* kg = A.in[11] + j * HD; const float* qg = A.in[10] + j * HD;
    const int jq = tid & 3;
    if (PART != 2) {
#pragma unroll 1
    for (int pass = 0; pass < 2; ++pass) {
        const int slot = pass * 128 + (tid >> 2), pos = (qb - 1) * 128 + slot;
        if (pos < 0) stage_zero(Ks, Vt, slot, jq);
        else {
            const size_t row = (size_t)b * T + pos; const bool last = (qb == 15) && (pass == 1);
            const size_t oo = ((((size_t)j * NB + b) * WIN + (slot - 128)) * NKV + g) * HD;
            stage_k<false, true, true>(Ks, slot, jq, Z + row * ATT_IN + 768 + g * HD, kg, rope + (size_t)pos * 64, last ? A.out + O_SWAK_P + oo : nullptr);
            stage_v<false>(Vt, slot, jq, Z + row * ATT_IN + 1024 + g * HD, last ? A.out + O_SWAV_P + oo : nullptr);
        }
    }
    }
    if (PART == 0) __syncthreads();
    const int r16 = lane & 15, q4 = lane >> 4;
    if (PART != 1 && (PART == 0 || wave >= 1)) {
    const int g0 = (PART == 0) ? wave : wave - 1, gs = (PART == 0) ? NWAVES : NWAVES - 1;
#pragma unroll 1
    for (int gk = 0; gk < 4; ++gk) { const int gi = g0 + gk * gs; if (gi >= 24) break;
        const int hh = gi >> 3, qg16 = gi & 7, i = 16 * qg16 + r16, hq = g * 3 + hh, pos = qb * 128 + i;
        const size_t row = (size_t)b * T + pos;
        bf16x8 q0, q1; load_q<true>(Z + row * ATT_IN + hq * HD, q4, qg, rope + (size_t)pos * 64, q0, q1);
        int lo = i + 1; if (qb == 0 && lo < 128) lo = 128;
        attn_rows16<10>(Ks, Vt, 2 * (qg16 >> 1), q0, q1, lo, i + 128, A.in[12][j * NQ + hq], OB + row * D + hq * HD + 4 * q4, true, lane);
    }
    }
    if (PART == 0) __syncthreads();
}
template <int PART>
__device__ __forceinline__ void item_cross_prompt(const Args& A, LAS unsigned char* lds, int it, int li, int ldz, int xcol, int tid, int wave, int lane) {
    const int qp = it & 7, h = (it >> 3) & 3, b = it >> 5;
    const bf16* Z = (const bf16*)(A.ws + WS_Z); bf16* OB = (bf16*)(A.ws + WS_OB); const float* MR = (const float*)(A.ws + WS_MEMRAW);
    LAS unsigned char* Ks = lds + KS_OFF; LAS unsigned char* Vt = lds + VT_OFF;
    const float* kg = A.in[18] + li * HD; const float* qg = A.in[17] + li * HD;
    const int jq = tid & 3;
    if (PART != 2) {
#pragma unroll 1
    for (int pass = 0; pass < 2; ++pass) {
        const int slot = pass * 128 + (tid >> 2);
        const float* src = MR + (size_t)(b * NMEM + slot) * 2048 + li * 512 + h * HD;
        const size_t oo = ((((size_t)li * NB + b) * NMEM + slot) * NXH + h) * HD;
        stage_k<true, true, false>(Ks, slot, jq, src, kg, nullptr, qp == 0 ? A.out + O_MEMK_P + oo : nullptr);
        stage_v<true>(Vt, slot, jq, src + 256, qp == 0 ? A.out + O_MEMV_P + oo : nullptr);
    }
    }
    if (PART == 0) __syncthreads();
    const int r16 = lane & 15, q4 = lane >> 4;
    if (PART != 1 && (PART == 0 || wave >= 1)) {
    const int g0 = (PART == 0) ? wave : wave - 1, gs = (PART == 0) ? NWAVES : NWAVES - 1;
#pragma unroll 1
    for (int gk = 0; gk < 3; ++gk) { const int gi = g0 + gk * gs; if (gi >= 16) break;
        const size_t row = (size_t)b * T + qp * 256 + 16 * gi + r16;
        bf16x8 q0, q1; load_q<false>(Z + row * ldz + xcol + h * HD, q4, qg, nullptr, q0, q1);
        attn_rows16<16>(Ks, Vt, 0, q0, q1, 0, 255, -1e30f, OB + row * D + CONV_CH + h * HD + 4 * q4, true, lane);
    }
    }
    if (PART == 0) __syncthreads();
}
template <int PART>
__device__ __forceinline__ void item_swa_sample(const Args& A, LAS unsigned char* lds, int it, int j, int tid, int wave, int lane) {
    const int g = it & 3, b = it >> 2;
    const bf16* Z = (const bf16*)(A.ws + WS_Z); bf16* OB = (bf16*)(A.ws + WS_OB); const float* rope = (const float*)(A.ws + WS_ROPE);
    LAS unsigned char* Ks = lds + KS_OFF; LAS unsigned char* Vt = lds + VT_OFF;
    const float* kg = A.in[11] + j * HD; const float* qg = A.in[10] + j * HD;
    const int jq = tid & 3;
    if (PART != 2) {
    {
        const int slot = tid >> 2;
        const size_t so = ((((size_t)j * NS + b) * WIN + slot) * NKV + g) * HD, oo = ((((size_t)j * NS + b) * WIN + (slot - 4)) * NKV + g) * HD;
        stage_k<true, false, false>(Ks, slot, jq, A.in[3] + so, nullptr, nullptr, slot >= 4 ? A.out + O_SWAK_S + oo : nullptr);
        stage_v<true>(Vt, slot, jq, A.in[4] + so, slot >= 4 ? A.out + O_SWAV_S + oo : nullptr);
    }
    if (tid < 128) {
        const int slot = 128 + (tid >> 2), t = slot - 128;
        if (t < TS) {
            const size_t row = (size_t)MP + b * TS + t, oo = ((((size_t)j * NS + b) * WIN + (slot - 4)) * NKV + g) * HD;
            stage_k<false, true, true>(Ks, slot, jq, Z + row * ATT_IN + 768 + g * HD, kg, rope + (size_t)(T + t) * 64, A.out + O_SWAK_S + oo);
            stage_v<false>(Vt, slot, jq, Z + row * ATT_IN + 1024 + g * HD, A.out + O_SWAV_S + oo);
        } else stage_zero(Ks, Vt, slot, jq);
    }
    }
    if (PART == 0) __syncthreads();
    if (PART != 1 && wave == 0) {
        const int r16 = lane & 15, q4 = lane >> 4;
        const bool valid = r16 < 12; const int hh = valid ? (r16 >> 2) : 2, t = r16 & 3, hq = g * 3 + hh;
        const size_t row = (size_t)MP + b * TS + t;
        bf16x8 q0, q1; load_q<true>(Z + row * ATT_IN + hq * HD, q4, qg, rope + (size_t)(T + t) * 64, q0, q1);
        attn_rows16<10>(Ks, Vt, 0, q0, q1, t + 1, 128 + t, A.in[12][j * NQ + hq], OB + row * D + hq * HD + 4 * q4, valid, lane);
    }
    if (PART == 0) __syncthreads();
}
template <int PART>
__device__ __forceinline__ void item_cross_sample(const Args& A, LAS unsigned char* lds, int it, int li, int ldz, int xcol, int tid, int wave, int lane) {
    const int h = it & 3, b = it >> 2;
    const bf16* Z = (const bf16*)(A.ws + WS_Z); bf16* OB = (bf16*)(A.ws + WS_OB);
    LAS unsigned char* Ks = lds + KS_OFF; LAS unsigned char* Vt = lds + VT_OFF;
    const float* qg = A.in[17] + li * HD;
    const int jq = tid & 3;
    if (PART != 2) {
#pragma unroll
    for (int pass = 0; pass < 2; ++pass) {
        const int slot = pass * 128 + (tid >> 2);
        const size_t so = ((((size_t)li * NS + b) * NMEM + slot) * NXH + h) * HD;
        stage_k<true, false, false>(Ks, slot, jq, A.in[6] + so, nullptr, nullptr, nullptr);
        stage_v<true>(Vt, slot, jq, A.in[7] + so, nullptr);
    }
    }
    if (PART == 0) __syncthreads();
    if (PART != 1 && wave == 0) {
        const int r16 = lane & 15, q4 = lane >> 4;
        const bool valid = r16 < 4; const int t = r16 & 3;
        const size_t row = (size_t)MP + b * TS + t;
        bf16x8 q0, q1; load_q<false>(Z + row * ldz + xcol + h * HD, q4, qg, nullptr, q0, q1);
        attn_rows16<16>(Ks, Vt, 0, q0, q1, 0, 255, -1e30f, OB + row * D + CONV_CH + h * HD + 4 * q4, valid, lane);
    }
    if (PART == 0) __syncthreads();
}
struct SReg { unsigned w[32]; };
__device__ __forceinline__ void cross_sample_load(const Args& A, int it, int li, int tid, SReg& R) {
    const int h = it & 3, b = it >> 2, jq = tid & 3;
#pragma unroll
    for (int pass = 0; pass < 2; ++pass) {
        const int slot = pass * 128 + (tid >> 2);
        const size_t so = ((((size_t)li * NS + b) * NMEM + slot) * NXH + h) * HD;
        float a[8], c[8];
        ld8<true>(A.in[6] + so + 8 * jq, a); ld8<true>(A.in[6] + so + 32 + 8 * jq, c);
        const u32x4 ka = pk8(a), kc = pk8(c);
        ld8<true>(A.in[7] + so + 16 * jq, a); ld8<true>(A.in[7] + so + 16 * jq + 8, c);
        const u32x4 va = pk8(a), vc = pk8(c);
        R.w[pass * 16 + 0] = ka.x; R.w[pass * 16 + 1] = ka.y; R.w[pass * 16 + 2] = ka.z; R.w[pass * 16 + 3] = ka.w;
        R.w[pass * 16 + 4] = kc.x; R.w[pass * 16 + 5] = kc.y; R.w[pass * 16 + 6] = kc.z; R.w[pass * 16 + 7] = kc.w;
        R.w[pass * 16 + 8] = va.x; R.w[pass * 16 + 9] = va.y; R.w[pass * 16 + 10] = va.z; R.w[pass * 16 + 11] = va.w;
        R.w[pass * 16 + 12] = vc.x; R.w[pass * 16 + 13] = vc.y; R.w[pass * 16 + 14] = vc.z; R.w[pass * 16 + 15] = vc.w;
    }
}
__device__ __forceinline__ void cross_sample_finish(LAS unsigned char* lds, int tid, const SReg& R) {
    LAS unsigned char* Ks = lds + KS_OFF; LAS unsigned char* Vt = lds + VT_OFF; const int jq = tid & 3;
#pragma unroll
    for (int pass = 0; pass < 2; ++pass) {
        const int slot = pass * 128 + (tid >> 2);
        *(LAS u32x4*)(Ks + slot * KS_STRIDE + 16 * jq) = (u32x4){R.w[pass * 16 + 0], R.w[pass * 16 + 1], R.w[pass * 16 + 2], R.w[pass * 16 + 3]};
        *(LAS u32x4*)(Ks + slot * KS_STRIDE + 64 + 16 * jq) = (u32x4){R.w[pass * 16 + 4], R.w[pass * 16 + 5], R.w[pass * 16 + 6], R.w[pass * 16 + 7]};
#pragma unroll
        for (int i = 0; i < 8; ++i) { const unsigned v = R.w[pass * 16 + 8 + i];
            *(LAS bf16*)(Vt + (16 * jq + 2 * i) * VT_STRIDE + slot * 2) = (bf16)(v & 0xffffu); *(LAS bf16*)(Vt + (16 * jq + 2 * i + 1) * VT_STRIDE + slot * 2) = (bf16)(v >> 16); }
    }
}
__device__ __forceinline__ void swa_sample_load(const Args& A, int it, int j, int tid, SReg& R) {
    const int g = it & 3, b = it >> 2, jq = tid & 3, slot = tid >> 2;
    const size_t so = ((((size_t)j * NS + b) * WIN + slot) * NKV + g) * HD;
    float a[8], c[8];
    ld8<true>(A.in[3] + so + 8 * jq, a); ld8<true>(A.in[3] + so + 32 + 8 * jq, c);
#pragma unroll
    for (int i = 0; i < 8; ++i) { R.w[i] = __builtin_bit_cast(unsigned, a[i]); R.w[8 + i] = __builtin_bit_cast(unsigned, c[i]); }
    ld8<true>(A.in[4] + so + 16 * jq, a); ld8<true>(A.in[4] + so + 16 * jq + 8, c);
#pragma unroll
    for (int i = 0; i < 8; ++i) { R.w[16 + i] = __builtin_bit_cast(unsigned, a[i]); R.w[24 + i] = __builtin_bit_cast(unsigned, c[i]); }
}
__device__ __forceinline__ void swa_sample_finish(const Args& A, LAS unsigned char* lds, int it, int j, int tid, const SReg& R) {
    const int g = it & 3, b = it >> 2, jq = tid & 3;
    const bf16* Z = (const bf16*)(A.ws + WS_Z); const float* rope = (const float*)(A.ws + WS_ROPE);
    LAS unsigned char* Ks = lds + KS_OFF; LAS unsigned char* Vt = lds + VT_OFF;
    {
        const int slot = tid >> 2;
        float ka[8], kc[8], va[8], vc[8];
#pragma unroll
        for (int i = 0; i < 8; ++i) { ka[i] = __builtin_bit_cast(float, R.w[i]); kc[i] = __builtin_bit_cast(float, R.w[8 + i]); va[i] = __builtin_bit_cast(float, R.w[16 + i]); vc[i] = __builtin_bit_cast(float, R.w[24 + i]); }
        if (slot >= 4) { const size_t oo = ((((size_t)j * NS + b) * WIN + (slot - 4)) * NKV + g) * HD;
            st8f(A.out + O_SWAK_S + oo + 8 * jq, ka); st8f(A.out + O_SWAK_S + oo + 32 + 8 * jq, kc);
            st8f(A.out + O_SWAV_S + oo + 16 * jq, va); st8f(A.out + O_SWAV_S + oo + 16 * jq + 8, vc); }
        *(LAS u32x4*)(Ks + slot * KS_STRIDE + 16 * jq) = pk8(ka); *(LAS u32x4*)(Ks + slot * KS_STRIDE + 64 + 16 * jq) = pk8(kc);
#pragma unroll
        for (int i = 0; i < 8; ++i) { *(LAS bf16*)(Vt + (16 * jq + i) * VT_STRIDE + slot * 2) = (bf16)f2bf(va[i]); *(LAS bf16*)(Vt + (16 * jq + 8 + i) * VT_STRIDE + slot * 2) = (bf16)f2bf(vc[i]); }
    }
    if (tid < 128) {
        const int slot = 128 + (tid >> 2), t = slot - 128;
        if (t < TS) {
            const size_t row = (size_t)MP + b * TS + t, oo = ((((size_t)j * NS + b) * WIN + (slot - 4)) * NKV + g) * HD;
            stage_k<false, true, true>(Ks, slot, jq, Z + row * ATT_IN + 768 + g * HD, A.in[11] + j * HD, rope + (size_t)(T + t) * 64, A.out + O_SWAK_S + oo);
            stage_v<false>(Vt, slot, jq, Z + row * ATT_IN + 1024 + g * HD, A.out + O_SWAV_S + oo);
        } else stage_zero(Ks, Vt, slot, jq);
    }
}
__device__ __forceinline__ void conv_items(const Args& A, int j, int gtid, int gthreads) {
    const bf16* Z = (const bf16*)(A.ws + WS_Z); bf16* OB = (bf16*)(A.ws + WS_OB);
    const float* cw = A.in[14] + (size_t)j * 3 * CONV_CH;
#pragma unroll 1
    for (int it = gtid; it < M * 96; it += gthreads) {
        const int row = it / 96, c0 = (it % 96) * 8;
        int t, b; const bool prompt = row < MP;
        if (prompt) { b = row / T; t = row % T; } else { b = (row - MP) / TS; t = (row - MP) % TS; }
        const bf16* zr = Z + (size_t)row * CONV_IN + c0;
        float gb[8], gc[8], u[8], cu0[8], cu1[8], cu2[8], w0[8], w1[8], w2[8];
        ld8<false>(zr, gb); ld8<false>(zr + CONV_CH, gc); ld8<false>(zr + 2 * CONV_CH, u);
#pragma unroll
        for (int i = 0; i < 8; ++i) cu2[i] = gc[i] * u[i];
        if (t >= 1) { ld8<false>(zr - CONV_IN + CONV_CH, gc); ld8<false>(zr - CONV_IN + 2 * CONV_CH, u);
#pragma unroll
            for (int i = 0; i < 8; ++i) cu1[i] = gc[i] * u[i]; }
        else if (prompt) {
#pragma unroll
            for (int i = 0; i < 8; ++i) cu1[i] = 0.f; }
        else ld8<true>(A.in[5] + (((size_t)j * NS + b) * 2 + 1) * CONV_CH + c0, cu1);
        if (t >= 2) { ld8<false>(zr - 2 * CONV_IN + CONV_CH, gc); ld8<false>(zr - 2 * CONV_IN + 2 * CONV_CH, u);
#pragma unroll
            for (int i = 0; i < 8; ++i) cu0[i] = gc[i] * u[i]; }
        else if (prompt) {
#pragma unroll
            for (int i = 0; i < 8; ++i) cu0[i] = 0.f; }
        else ld8<true>(A.in[5] + (((size_t)j * NS + b) * 2 + t) * CONV_CH + c0, cu0);
        ld8<true>(cw + c0, w0); ld8<true>(cw + CONV_CH + c0, w1); ld8<true>(cw + 2 * CONV_CH + c0, w2);
        float o[8];
#pragma unroll
        for (int i = 0; i < 8; ++i) o[i] = gb[i] * (w0[i] * cu0[i] + w1[i] * cu1[i] + w2[i] * cu2[i]);
        *(u32x4*)(OB + (size_t)row * D + c0) = pk8(o);
        if (prompt) { if (t >= T - 2) st8f(A.out + O_CONV_P + (((size_t)j * NB + b) * 2 + (t - (T - 2))) * CONV_CH + c0, cu2); }
        else { if (t >= TS - 2) st8f(A.out + O_CONV_S + (((size_t)j * NS + b) * 2 + (t - (TS - 2))) * CONV_CH + c0, cu2); }
    }
}

#ifndef TEST_MASK
#define TEST_MASK 63
#endif
constexpr int PHMASK = TEST_MASK;
#ifndef MIX_REP
#define MIX_REP 1
#endif
#ifndef P0_REP
#define P0_REP 1
#endif
__global__ void __launch_bounds__(NTHR, 2) trunk_fwd(Args A) {
    extern __shared__ __attribute__((aligned(16))) unsigned char lds_raw[];
    LAS unsigned char* lds = (LAS unsigned char*)lds_raw;
    cg::grid_group grid = cg::this_grid();
    if (threadIdx.x < 4) ((volatile LAS unsigned*)(lds + 147440))[threadIdx.x] = 0u;
    __syncthreads();
    const XcdBarrier xbar = xcd_barrier_post((unsigned*)(A.ws + WS_BAR), (volatile LAS unsigned*)(lds + 147440));
    if (A.ph_lo > A.ph_hi) grid.sync();
    const int tid0 = threadIdx.x;
#define LAUNDER_TID() int tid = tid0; asm volatile("" : "+v"(tid)); const int lane = tid & 63, wave = __builtin_amdgcn_readfirstlane(tid >> 6); (void)lane; (void)wave
    const int G = gridDim.x, bx = blockIdx.x;
    const int lo = A.ph_lo, hi = A.ph_hi;
    unsigned char* ws = A.ws;
    float* rowss = (float*)(ws + WS_ROWSS); float* memss = (float*)(ws + WS_MEMSS);
    bf16* XB = (bf16*)(ws + WS_XB); bf16* OB = (bf16*)(ws + WS_OB); bf16* Z = (bf16*)(ws + WS_Z); bf16* ACT = (bf16*)(ws + WS_ACT);
    float* X = A.out + O_Y;
#define IN(k) (lo <= (k) && (k) < hi)
#define SEAM(k) do { if (IN(k) && IN((k) + 1)) { asm volatile("s_waitcnt vmcnt(0) lgkmcnt(0)" ::: "memory"); xcd_barrier(xbar); } } while (0)

    if (IN(0) && (PHMASK & 1)) {
      for (int rep = 0; rep < P0_REP; ++rep) {
        LAUNDER_TID();
        LAS float* scr = (LAS float*)(lds + wave * SCR_WAVE_BYTES);
        const int gw = bx * NWAVES + wave, NGW = G * NWAVES, gtid = bx * NTHR + tid, gthreads = G * NTHR;
        for (int i = gtid; i < (T + TS) * 32; i += gthreads) { const int p = i >> 5, f = i & 31; const double pos = (p < T) ? (double)p : (double)(8192 + p - T);
            float c, s; sincos_d(pos * INV_FREQ[f], c, s); float* rt = (float*)(ws + WS_ROPE) + (size_t)p * 64; rt[f] = c; rt[32 + f] = s; }
        for (int m = gw; m < M + MEMROWS; m += NGW) {
            if (m < M) { const float* src = (m < MP) ? A.in[0] + (size_t)m * D : A.in[1] + (size_t)(m - MP) * D;
                const float s = row_to_bf16(src, XB + (size_t)m * D, nullptr, lane); if (lane < 16) rowss[(size_t)m * 16 + lane] = (lane == 0) ? s : 0.f; }
            else { const int r = m - M; const float s = row_to_bf16(A.in[2] + (size_t)r * D, (bf16*)(ws + WS_MEMB) + (size_t)r * D, nullptr, lane); if (lane == 0) memss[r] = s; }
        }
        constexpr int I_INA = 16 * 24, I_INC = 16 * 40, I_MEM = 16 * 8, I_OUT = 16 * 16, I_UP = 16 * 64, I_DN = 64 * 16;
        constexpr int NITEMS = 2 * I_INA + 2 * I_INC + 4 * I_MEM + 4 * I_OUT + 4 * I_UP + 4 * I_DN;
#pragma unroll 1
        for (int it = gw; it < NITEMS; it += NGW) {
            int r = it;
            if (r < 2 * I_INA) { const int l = r / I_INA; p0_transpose_item(A.in[9] + (size_t)l * D * ATT_IN, D, ATT_IN, (bf16*)(ws + WS_WINA) + (size_t)l * ATT_IN * D, A.in[8] + (2 * l) * D, scr, r % I_INA, lane); continue; } r -= 2 * I_INA;
            if (r < 2 * I_INC) { const int l = r / I_INC; p0_transpose_item(A.in[13] + (size_t)l * D * CONV_IN, D, CONV_IN, (bf16*)(ws + WS_WINC) + (size_t)l * CONV_IN * D, A.in[8] + (2 * l + 1) * D, scr, r % I_INC, lane); continue; } r -= 2 * I_INC;
            if (r < 4 * I_MEM) { const int l = r / I_MEM; p0_transpose_item(A.in[16] + (size_t)l * D * 512, D, 512, (bf16*)(ws + WS_WMEM) + (size_t)l * 512 * D, A.in[15] + l * D, scr, r % I_MEM, lane); continue; } r -= 4 * I_MEM;
            if (r < 4 * I_OUT) { const int l = r / I_OUT; p0_transpose_item(A.in[19] + (size_t)l * D * D, D, D, (bf16*)(ws + WS_WOUT) + (size_t)l * D * D, nullptr, scr, r % I_OUT, lane); continue; } r -= 4 * I_OUT;
            if (r < 4 * I_UP) { const int l = r / I_UP; p0_transpose_item(A.in[21] + (size_t)l * D * FF, D, FF, (bf16*)(ws + WS_WUP) + (size_t)l * FF * D, A.in[20] + l * D, scr, r % I_UP, lane); continue; } r -= 4 * I_UP;
            { const int l = r / I_DN; p0_transpose_item(A.in[22] + (size_t)l * FF * D, FF, D, (bf16*)(ws + WS_WDN) + (size_t)l * D * FF, nullptr, scr, r % I_DN, lane); }
        }
        __syncthreads();
      }
    }
    SEAM(0);

#pragma unroll 1
    for (int li = 0; li < DEPTH; ++li) {
        const int p0 = 1 + 5 * li, j = li >> 1; const bool att = (li & 1) == 0;
        const int nin = att ? ATT_IN : CONV_IN, xcol = att ? 1280 : 2304;
        if (IN(p0) && (PHMASK & 2)) {
            const bf16* W = att ? (const bf16*)(ws + WS_WINA) + (size_t)j * ATT_IN * D : (const bf16*)(ws + WS_WINC) + (size_t)j * CONV_IN * D;
            pg8::Gemm g{XB, W, M, nin, D}; pg8::StaticOrder S; S.init(M, nin, G, bx);
            pg8::EpiScale<0, true, true> E{Z, nin, rowss + (size_t)(2 * li) * M * 16, lds + 131072, (G == 256) ? MP / 256 : 0};
            pg8::gemm_phase<pg8::EpiScale<0, true, true>, pg8::StaticOrder, true, true>(lds, g, S, E);
            if (li == 0) {
                pg8::Gemm g2{(const bf16*)(ws + WS_MEMB), (const bf16*)(ws + WS_WMEM), MEMROWS, 2048, D}; pg8::StaticOrder S2; S2.init(MEMROWS, 2048, G, G - 1 - bx);
                pg8::EpiScaleF32 E2{(float*)(ws + WS_MEMRAW), 2048, memss};
                pg8::gemm_phase<pg8::EpiScaleF32, pg8::StaticOrder, true, true>(lds, g2, S2, E2);
            }
        }
        SEAM(p0);
        if (IN(p0 + 1) && (PHMASK & 4)) {
          for (int rep = 0; rep < MIX_REP; ++rep) {
            LAUNDER_TID();
            if (G == 256) {
                constexpr int REG1 = 70656;
                const int nP = att ? 3 : 1, nS = att ? 4 : 2;
                SReg R;
                if (att) swa_sample_load(A, bx, j, tid, R); else cross_sample_load(A, bx, li, tid, R);
#pragma unroll 1
                for (int k = 0; k < nS; ++k) {
                    const bool hp = k < nP, swp = att && k < 2, sws = att && k < 2;
                    const int its = bx + ((att ? (k & 1) : k) << 8);
                    if (hp) { if (swp) item_swa_prompt<1>(A, lds, bx + (k << 8), j, tid, wave, lane); else item_cross_prompt<1>(A, lds, bx, li, nin, xcol, tid, wave, lane); }
                    if (sws) swa_sample_finish(A, lds + REG1, its, j, tid, R); else cross_sample_finish(lds + REG1, tid, R);
                    __syncthreads();
                    if (k + 1 < nS) {
                        const int k1 = k + 1, its1 = bx + ((att ? (k1 & 1) : k1) << 8);
                        if (att && k1 < 2) swa_sample_load(A, its1, j, tid, R); else cross_sample_load(A, its1, li, tid, R);
                    }
                    if (hp) { if (swp) item_swa_prompt<2>(A, lds, bx + (k << 8), j, tid, wave, lane); else item_cross_prompt<2>(A, lds, bx, li, nin, xcol, tid, wave, lane); }
                    if (sws) item_swa_sample<2>(A, lds + REG1, its, j, tid, wave, lane); else item_cross_sample<2>(A, lds + REG1, its, li, nin, xcol, tid, wave, lane);
                    if (!att && k == nS - 1) conv_items(A, j, bx * NTHR + tid, G * NTHR);
                    __syncthreads();
                }
            } else {
            if (att) {
#pragma unroll 1
                for (int it = bx; it < 512; it += G) item_swa_prompt<0>(A, lds, it, j, tid, wave, lane);
            }
#pragma unroll 1
            for (int it = bx; it < 256; it += G) item_cross_prompt<0>(A, lds, it, li, nin, xcol, tid, wave, lane);
            if (att) {
#pragma unroll 1
                for (int it = bx; it < 512; it += G) item_swa_sample<0>(A, lds, it, j, tid, wave, lane);
            }
#pragma unroll 1
            for (int it = bx; it < 512; it += G) item_cross_sample<0>(A, lds, it, li, nin, xcol, tid, wave, lane);
            }
            if (!att && G != 256) conv_items(A, j, bx * NTHR + tid, G * NTHR);
          }
        }
        SEAM(p0 + 1);
        if (IN(p0 + 2) && (PHMASK & 8)) {
            const bf16* W = (const bf16*)(ws + WS_WOUT) + (size_t)li * D * D;
            pg8::Gemm g{OB, W, MP, D, D}; pg8::StaticOrder S; S.init(MP, D, G, bx);
            pg8::EpiRes E{nullptr, XB, rowss + (size_t)(2 * li + 1) * M * 16, nullptr};
            if (G == 256) { pg8::EpiResT ET{nullptr, XB, rowss + (size_t)(2 * li + 1) * M * 16, nullptr}; pg8::gemm_phase<pg8::EpiResT, pg8::StaticOrder, true, true>(lds, g, S, ET); }
            else pg8::gemm_phase<pg8::EpiRes, pg8::StaticOrder, true, true>(lds, g, S, E);
            { LAUNDER_TID(); SkRes SE{nullptr, XB, rowss + (size_t)(2 * li + 1) * M * 16, nullptr}; skinny_gemm<4, 1, 8, SkRes>(lds, OB, W, D, SE, bx, 1, tid); }
        }
        SEAM(p0 + 2);
        if (IN(p0 + 3) && (PHMASK & 16)) {
            const bf16* W = (const bf16*)(ws + WS_WUP) + (size_t)li * FF * D;
            pg8::Gemm g{XB, W, MP, FF, D}; pg8::StaticOrder S; S.init(MP, FF, G, bx);
            pg8::EpiScale<2, false, true> E{ACT, FF, nullptr, lds + 131072, 0};
            pg8::gemm_phase<pg8::EpiScale<2, false, true>, pg8::StaticOrder, true, true>(lds, g, S, E);
            { LAUNDER_TID(); SkScale<2, false> SE{ACT, FF, nullptr}; skinny_gemm<4, 4, 2, SkScale<2, false>>(lds, XB, W, D, SE, bx, 1, tid); }
        }
        SEAM(p0 + 3);
        if (IN(p0 + 4) && (PHMASK & 32)) {
            const bf16* W = (const bf16*)(ws + WS_WDN) + (size_t)li * D * FF;
            pg8::Gemm g{ACT, W, MP, D, FF}; pg8::StaticOrder S; S.init(MP, D, G, bx);
            pg8::EpiRes E{(li == DEPTH - 1) ? X : nullptr, XB, rowss + (size_t)(2 * li + 2) * M * 16, rowss + (size_t)(2 * li + 1) * M * 16};
            if (G == 256) { pg8::EpiResT ET{(li == DEPTH - 1) ? X : nullptr, XB, rowss + (size_t)(2 * li + 2) * M * 16, rowss + (size_t)(2 * li + 1) * M * 16}; pg8::gemm_phase<pg8::EpiResT, pg8::StaticOrder, true, true>(lds, g, S, ET); }
            else pg8::gemm_phase<pg8::EpiRes, pg8::StaticOrder, true, true>(lds, g, S, E);
            { LAUNDER_TID(); SkRes SE{(li == DEPTH - 1) ? X : nullptr, XB, rowss + (size_t)(2 * li + 2) * M * 16, rowss + (size_t)(2 * li + 1) * M * 16}; skinny_gemm<4, 1, 8, SkRes>(lds, ACT, W, FF, SE, bx, 1, tid); }
        }
        SEAM(p0 + 4);
    }
#undef IN
#undef SEAM
}

#ifndef N_LAUNCHES
#define N_LAUNCHES 1
#endif
extern "C" void kernel_launch(void* const* d_in, const int* in_sizes, int n_in, void* d_out, int out_size, void* d_ws, size_t ws_size, hipStream_t stream) {
    static int grid = 0;
    if (grid == 0) {
        if (n_in != 23 || (size_t)out_size != O_END || ws_size < WS_END) { fprintf(stderr, "kernel_launch: unexpected shapes: n_in %d out %d ws %zu\n", n_in, out_size, ws_size); grid = -1; return; }
        int dev = 0, cus = 0, per_cu = 0;
        if (hipGetDevice(&dev) != hipSuccess || hipDeviceGetAttribute(&cus, hipDeviceAttributeMultiprocessorCount, dev) != hipSuccess) { grid = -1; return; }
        if (hipFuncSetAttribute((const void*)trunk_fwd, hipFuncAttributeMaxDynamicSharedMemorySize, LDS_BYTES) != hipSuccess) { fprintf(stderr, "kernel_launch: hipFuncSetAttribute failed\n"); grid = -1; return; }
        if (hipOccupancyMaxActiveBlocksPerMultiprocessor(&per_cu, (const void*)trunk_fwd, NTHR, LDS_BYTES) != hipSuccess || per_cu < 1) { fprintf(stderr, "kernel_launch: occupancy query failed (%d)\n", per_cu); (void)hipGetLastError(); grid = -1; return; }
        grid = cus * per_cu;
        fprintf(stderr, "kernel_launch: grid %d (cus %d x %d)\n", grid, cus, per_cu);
    }
    if (grid < 0) return;
    if (hipMemsetAsync((char*)d_ws + WS_BAR, 0, XCD_BAR_WORDS * 4, stream) != hipSuccess) { fprintf(stderr, "kernel_launch: memset failed\n"); return; }
    Args a{};
    for (int i = 0; i < 23; ++i) a.in[i] = (const float*)d_in[i];
    a.out = (float*)d_out; a.ws = (unsigned char*)d_ws;
#if N_LAUNCHES == 1
    a.ph_lo = 0; a.ph_hi = NPH;
    void* args[] = {&a};
    hipError_t e = hipLaunchCooperativeKernel((const void*)trunk_fwd, dim3(grid), dim3(NTHR), args, LDS_BYTES, stream);
    if (e != hipSuccess) fprintf(stderr, "kernel_launch: cooperative launch failed: %s (grid %d)\n", hipGetErrorString(e), grid);
#else
    for (int p = 0; p < NPH; ++p) { a.ph_lo = p; a.ph_hi = p + 1; hipLaunchKernelGGL(trunk_fwd, dim3(grid), dim3(NTHR), LDS_BYTES, stream, a); }
#endif
}
```
